# Optimizing an MI355X kernel written in HIP

```python
import math
import jax, jax.numpy as jnp
from jax import lax
import numpy as np

D_MODEL = 1024
BATCH = 8
SEQ = 4096
DEPTH = 2

N_EVEN = (DEPTH + 1) // 2
N_ODD = DEPTH // 2

A_QK_DIM = 64
A_V_DIM = 2 * A_QK_DIM
A_WIDTH = D_MODEL // 2
A_HEADS = A_WIDTH // A_V_DIM
ROPE_DIM = A_QK_DIM // 4
ROPE_THETA = 500000.0
Q_BLOCK = 128

B_WIDTH = D_MODEL // 2
B_HEADS = 8
B_HEAD_DIM = B_WIDTH // B_HEADS
CONV_WIDTH = 4
LRU_C = 8.0

IN_WIDTH = 3 * A_WIDTH + 2 * B_WIDTH

POOL_WINDOWS = (2, 4, 8, 16)
POOL_GROUPS = len(POOL_WINDOWS)
POOL_GROUP_DIM = D_MODEL // POOL_GROUPS

FFN_DIM = 2816
N_EXPERTS = 8
TOP_K = 2
EXPERT_DIM = 3584

NORM_EPS = 1e-6
SUBLN_EPS = 1e-5

kernel_name = "hybrid_diffattn_rglru_pool_moe"


def rms_norm(x, g, eps=NORM_EPS):
    xf = x.astype(jnp.float32)
    y = xf * lax.rsqrt(jnp.mean(xf * xf, axis=-1, keepdims=True) + eps)
    return (y * g.astype(jnp.float32)).astype(x.dtype)


def rope_tables(seq):
    inv = ROPE_THETA ** (-jnp.arange(0, ROPE_DIM, 2, dtype=jnp.float32) / ROPE_DIM)
    ang = jnp.arange(seq, dtype=jnp.float32)[:, None] * inv[None, :]
    return jnp.cos(ang), jnp.sin(ang)


def apply_partial_rope(x, cos, sin):
    half = ROPE_DIM // 2
    x1 = x[..., :half].astype(jnp.float32)
    x2 = x[..., half:ROPE_DIM].astype(jnp.float32)
    c = cos[None, :, None, None, :]
    s = sin[None, :, None, None, :]
    rot = jnp.concatenate([x1 * c - x2 * s, x2 * c + x1 * s], axis=-1).astype(x.dtype)
    return jnp.concatenate([rot, x[..., ROPE_DIM:]], axis=-1)


def diff_attention(q, k, v, lam, lam_init, subln_g):
    bsz, seq = q.shape[0], q.shape[1]
    nb = seq // Q_BLOCK
    q = q * (A_QK_DIM ** -0.5)
    qb = q.reshape(bsz, nb, Q_BLOCK, A_HEADS, 2, A_QK_DIM).transpose(1, 0, 2, 3, 4, 5)
    key_pos = jnp.arange(seq)

    def block(args):
        q_blk, bi = args
        s = jnp.einsum("bqhmd,bkhmd->bhmqk", q_blk, k).astype(jnp.float32)
        q_pos = bi * Q_BLOCK + jnp.arange(Q_BLOCK)
        mask = key_pos[None, :] <= q_pos[:, None]
        p = jax.nn.softmax(jnp.where(mask, s, -jnp.inf), axis=-1)
        w = p[:, :, 0] - lam * p[:, :, 1]
        return jnp.einsum("bhqk,bkhd->bqhd", w.astype(v.dtype), v)

    o = lax.map(block, (qb, jnp.arange(nb)))
    o = o.transpose(1, 0, 2, 3, 4).reshape(bsz, seq, A_HEADS, A_V_DIM)
    o = rms_norm(o, subln_g, SUBLN_EPS) * (1.0 - lam_init)
    return o.reshape(bsz, seq, A_WIDTH)


def causal_depthwise_conv(x, w, b):
    y = lax.conv_general_dilated(
        x, w[:, None, :], window_strides=(1,), padding=[(CONV_WIDTH - 1, 0)],
        dimension_numbers=("NWC", "WIO", "NWC"), feature_group_count=x.shape[-1])
    return y + b


def rg_lru(x, wa, ba, wx, bx, lam):
    bsz, seq, ch = x.shape
    xh = x.reshape(bsz, seq, B_HEADS, B_HEAD_DIM)
    r = jax.nn.sigmoid((jnp.einsum("bshi,hij->bshj", xh, wa) + ba).astype(jnp.float32)).reshape(bsz, seq, ch)
    i = jax.nn.sigmoid((jnp.einsum("bshi,hij->bshj", xh, wx) + bx).astype(jnp.float32)).reshape(bsz, seq, ch)
    log_a = -LRU_C * r * jax.nn.softplus(-lam.astype(jnp.float32))
    a = jnp.exp(log_a)
    u = jnp.sqrt(-jnp.expm1(2.0 * log_a)) * (i * x.astype(jnp.float32))

    def combine(left, right):
        a1, b1 = left
        a2, b2 = right
        return a1 * a2, a2 * b1 + b2

    _, h = lax.associative_scan(combine, (a, u), axis=1)
    return h.astype(x.dtype)


def even_mixer(h, w_in, lq1, lk1, lq2, lk2, subln_g, conv_w, conv_b,
               wa, ba, wx, bx, lam_p, w_out, lam_init, cos, sin):
    bsz, seq, _ = h.shape
    proj = h @ w_in
    q, k, v, xb, gb = jnp.split(
        proj, [A_WIDTH, 2 * A_WIDTH, 3 * A_WIDTH, 3 * A_WIDTH + B_WIDTH], axis=-1)
    q = apply_partial_rope(q.reshape(bsz, seq, A_HEADS, 2, A_QK_DIM), cos, sin)
    k = apply_partial_rope(k.reshape(bsz, seq, A_HEADS, 2, A_QK_DIM), cos, sin)
    v = v.reshape(bsz, seq, A_HEADS, A_V_DIM)
    lam = (jnp.exp(jnp.sum(lq1.astype(jnp.float32) * lk1.astype(jnp.float32)))
           - jnp.exp(jnp.sum(lq2.astype(jnp.float32) * lk2.astype(jnp.float32)))
           + lam_init)
    attn = diff_attention(q, k, v, lam, lam_init, subln_g)
    rec = rg_lru(causal_depthwise_conv(xb, conv_w, conv_b), wa, ba, wx, bx, lam_p)
    rec = rec * jax.nn.gelu(gb)
    return jnp.concatenate([attn, rec], axis=-1) @ w_out


def pool_mixer(h, pool_w, pool_scale):
    bsz, seq, _ = h.shape
    hg = h.reshape(bsz, seq, POOL_GROUPS, POOL_GROUP_DIM)
    pos = jnp.arange(seq)
    outs = []
    for g, w in enumerate(POOL_WINDOWS):
        xg = hg[:, :, g].astype(jnp.float32)
        cs = jnp.cumsum(xg, axis=1)
        lower = jnp.pad(cs, ((0, 0), (w, 0), (0, 0)))[:, :seq]
        count = jnp.minimum(pos + 1, w).astype(jnp.float32)[None, :, None]
        outs.append((cs - lower) / count - xg)
    d = jnp.stack(outs, axis=2).astype(h.dtype)
    y = jnp.einsum("bsgc,gcd->bsgd", d, pool_w).reshape(bsz, seq, D_MODEL)
    return y * pool_scale


def swiglu(h, wg, wu, wd):
    return (jax.nn.silu(h @ wg) * (h @ wu)) @ wd


def moe_swiglu(h, router_w, wg, wu, wd):
    bsz, seq, dm = h.shape
    t = h.reshape(-1, dm)
    logits = (t @ router_w).astype(jnp.float32)
    top_val, top_idx = lax.top_k(logits, TOP_K)
    gates = jax.nn.softmax(top_val, axis=-1)
    combine = jnp.sum(jax.nn.one_hot(top_idx, N_EXPERTS, dtype=jnp.float32) * gates[..., None], axis=1)
    out = jnp.zeros_like(t)
    for e in range(N_EXPERTS):
        he = jax.nn.silu(t @ wg[e]) * (t @ wu[e])
        out = out + (combine[:, e:e + 1].astype(t.dtype) * he) @ wd[e]
    return out.reshape(bsz, seq, dm)


def setup_inputs(seed: int = 0) -> dict:
    key = jax.random.key(seed)
    ks = iter(jax.random.split(key, 40))
    f32 = jnp.float32

    def nrm(shape, scale):
        return jax.random.normal(next(ks), shape, f32) * scale

    def gain(shape):
        return 1.0 + 0.02 * jax.random.normal(next(ks), shape, f32)

    x = jax.random.normal(next(ks), (BATCH, SEQ, D_MODEL), f32)
    u = jax.random.uniform(next(ks), (N_EVEN, B_WIDTH), f32, 0.9, 0.999)
    s = u ** (1.0 / LRU_C)
    rg_lam = jnp.log(s / (1.0 - s))
    return {
        "x": x,
        "ln_mix_even": gain((N_EVEN, D_MODEL)),
        "w_in_even": nrm((N_EVEN, D_MODEL, IN_WIDTH), D_MODEL ** -0.5),
        "lam_q1": nrm((N_EVEN, A_QK_DIM), 0.1),
        "lam_k1": nrm((N_EVEN, A_QK_DIM), 0.1),
        "lam_q2": nrm((N_EVEN, A_QK_DIM), 0.1),
        "lam_k2": nrm((N_EVEN, A_QK_DIM), 0.1),
        "subln_g": gain((N_EVEN, A_V_DIM)),
        "conv_w": nrm((N_EVEN, CONV_WIDTH, B_WIDTH), CONV_WIDTH ** -0.5),
        "conv_b": nrm((N_EVEN, B_WIDTH), 0.01),
        "rg_wa": nrm((N_EVEN, B_HEADS, B_HEAD_DIM, B_HEAD_DIM), B_HEAD_DIM ** -0.5),
        "rg_ba": nrm((N_EVEN, B_HEADS, B_HEAD_DIM), 0.01),
        "rg_wx": nrm((N_EVEN, B_HEADS, B_HEAD_DIM, B_HEAD_DIM), B_HEAD_DIM ** -0.5),
        "rg_bx": nrm((N_EVEN, B_HEADS, B_HEAD_DIM), 0.01),
        "rg_lam": rg_lam,
        "w_out_even": nrm((N_EVEN, A_WIDTH + B_WIDTH, D_MODEL), (A_WIDTH + B_WIDTH) ** -0.5),
        "ln_ffn_even": gain((N_EVEN, D_MODEL)),
        "ffn_wg": nrm((N_EVEN, D_MODEL, FFN_DIM), D_MODEL ** -0.5),
        "ffn_wu": nrm((N_EVEN, D_MODEL, FFN_DIM), D_MODEL ** -0.5),
        "ffn_wd": nrm((N_EVEN, FFN_DIM, D_MODEL), FFN_DIM ** -0.5),
        "ln_mix_odd": gain((N_ODD, D_MODEL)),
        "pool_w": nrm((N_ODD, POOL_GROUPS, POOL_GROUP_DIM, POOL_GROUP_DIM), POOL_GROUP_DIM ** -0.5),
        "pool_scale": gain((N_ODD, D_MODEL)),
        "ln_ffn_odd": gain((N_ODD, D_MODEL)),
        "router_w": nrm((N_ODD, D_MODEL, N_EXPERTS), D_MODEL ** -0.5),
        "moe_wg": nrm((N_ODD, N_EXPERTS, D_MODEL, EXPERT_DIM), D_MODEL ** -0.5),
        "moe_wu": nrm((N_ODD, N_EXPERTS, D_MODEL, EXPERT_DIM), D_MODEL ** -0.5),
        "moe_wd": nrm((N_ODD, N_EXPERTS, EXPERT_DIM, D_MODEL), EXPERT_DIM ** -0.5),
        "final_g": gain((D_MODEL,)),
    }


def reference(x, ln_mix_even, w_in_even, lam_q1, lam_k1, lam_q2, lam_k2, subln_g,
              conv_w, conv_b, rg_wa, rg_ba, rg_wx, rg_bx, rg_lam, w_out_even,
              ln_ffn_even, ffn_wg, ffn_wu, ffn_wd, ln_mix_odd, pool_w, pool_scale,
              ln_ffn_odd, router_w, moe_wg, moe_wu, moe_wd, final_g):
    cos, sin = rope_tables(x.shape[1])
    h = x
    for layer in range(DEPTH):
        j = layer // 2
        if layer % 2 == 0:
            lam_init = 0.8 - 0.6 * math.exp(-0.3 * layer)
            h = h + even_mixer(rms_norm(h, ln_mix_even[j]), w_in_even[j],
                               lam_q1[j], lam_k1[j], lam_q2[j], lam_k2[j], subln_g[j],
                               conv_w[j], conv_b[j], rg_wa[j], rg_ba[j], rg_wx[j], rg_bx[j],
                               rg_lam[j], w_out_even[j], lam_init, cos, sin)
            h = h + swiglu(rms_norm(h, ln_ffn_even[j]), ffn_wg[j], ffn_wu[j], ffn_wd[j])
        else:
            h = h + pool_mixer(rms_norm(h, ln_mix_odd[j]), pool_w[j], pool_scale[j])
            h = h + moe_swiglu(rms_norm(h, ln_ffn_odd[j]), router_w[j],
                               moe_wg[j], moe_wu[j], moe_wd[j])
    return rms_norm(h, final_g)
```

```cpp
#include <hip/hip_runtime.h>
#include <hip/hip_bf16.h>
#include <cstdio>
#include <cstdint>
#include <cmath>
namespace pg8 {
#define PG8_LAS __attribute__((address_space(3)))
typedef unsigned short bf16_t;
typedef short bf16x8 __attribute__((ext_vector_type(8)));
typedef float f32x4 __attribute__((ext_vector_type(4)));
typedef unsigned u32x4 __attribute__((ext_vector_type(4)));
typedef unsigned u32x2 __attribute__((ext_vector_type(2)));
constexpr int BM = 256, BK = 64, HALF = 128, HTB = HALF * BK * 2  , STAGE_BYTES = 8 * HTB, NXCD = 8, WGM = 8;

__host__ __device__ __forceinline__ int lds_byte(int r, int c) { const int st = (r >> 4) * 2 + (c >> 5), rr = r & 15, cc = c & 31, ob = rr * 64 + cc * 2; return st * 1024 + (ob ^ (((ob >> 9) & 1) << 5)); }
__host__ __device__ __forceinline__ void stage_rc(int b, int& R, int& C) { const int st = b / 1024, sb = b % 1024, swz = sb ^ (((sb >> 9) & 1) << 5); R = (st >> 1) * 16 + swz / 64; C = (st & 1) * 32 + (swz % 64) / 2; }
__host__ __device__ __forceinline__ int perm32(int rho) { const int n = rho >> 4, i = rho & 15; return 8 * (i >> 2) + 4 * n + (i & 3); }

struct Unit { int pm, pn; };

struct StaticOrder {
    int nM, nN, nwg, G, c;
    __host__ __device__ void init(int M, int N, int G_, int c_) { nM = M / BM; nN = N / BM; nwg = nM * nN; G = G_; c = c_; }
    __host__ __device__ bool next(int i, Unit& u) const {
        const long L = (long)i * G + c; if (L >= nwg) return false;
        int wgid = (int)L; { const int q = nwg / NXCD, r = nwg % NXCD, xcd = wgid % NXCD, off = wgid / NXCD; wgid = (xcd < r ? xcd * (q + 1) : r * (q + 1) + (xcd - r) * q) + off; }
        const int nig = WGM * nN, gid = wgid / nig, fm = gid * WGM, gsz = (nM - fm) < WGM ? (nM - fm) : WGM;
        u.pm = fm + ((wgid % nig) % gsz); u.pn = (wgid % nig) / gsz; return true;
    }
};
struct GSched {
    StaticOrder so;
    const char* A; unsigned a_pm, a_pn;
    const char* B; unsigned b_pn, b_e;
    int tb[9];
    const int* rowidx; int pm0;
    __device__ __forceinline__ bool next(int i, Unit& u) const { return so.next(i, u); }
    __device__ __forceinline__ const char* a_ptr(const Unit& u) const { return A + (size_t)u.pm * a_pm + (size_t)u.pn * a_pn; }
    __device__ __forceinline__ const char* b_ptr(const Unit& u) const {
        size_t off = (size_t)u.pn * b_pn;
        if (b_e) { const int t = pm0 + u.pm; int e = 0;
#pragma unroll
            for (int j = 1; j < 8; ++j) e += (t >= tb[j]) ? 1 : 0;
            off += (size_t)e * b_e; }
        return B + off;
    }
};

__device__ __forceinline__ unsigned cvt_pk_bf16(float lo, float hi) { unsigned r; asm volatile("v_cvt_pk_bf16_f32 %0, %1, %2" : "=v"(r) : "v"(lo), "v"(hi)); return r; }

constexpr float C2 = 0.125f * 1.4426950408889634f;

struct EpiInProj {
    static constexpr bool PERM = true;
    bf16_t* O; const float* rope;
    __device__ __forceinline__ void operator()(const f32x4 (&acc)[2][2][4][2], const Unit& u, int wr, int wc, int fr, int fq) const {
        const int row0 = u.pm * BM + wr * 64 + fr, col0 = u.pn * BM + wc * 32 + 8 * fq;
        const float sc = (u.pn < 2) ? C2 : 1.f;
        const bool ropew = (u.pn < 4) && ((wc & 1) == 0);
        const float sgn = (fq == 0) ? -1.f : 1.f;
#pragma unroll
        for (int ai = 0; ai < 2; ++ai)
#pragma unroll
            for (int m = 0; m < 4; ++m) {
                const int row = row0 + ai * HALF + m * 16; bf16_t* rowp = O + (size_t)row * 2560 + col0;
                f32x4 cs[4];
                if (ropew) { const f32x4* tp = (const f32x4*)(rope + (size_t)(row & 4095) * 16); cs[0] = tp[0]; cs[1] = tp[1]; cs[2] = tp[2]; cs[3] = tp[3]; }
#pragma unroll
                for (int bj = 0; bj < 2; ++bj) {
                    f32x4 v0 = acc[ai][bj][m][0], v1 = acc[ai][bj][m][1];
                    if (ropew) {
                        f32x4 p0, p1;
#pragma unroll
                        for (int j = 0; j < 4; ++j) { p0[j] = __shfl_xor(v0[j], 16); p1[j] = __shfl_xor(v1[j], 16); }
                        if (fq < 2) {
                            v0[0] = v0[0] * cs[0][0] + sgn * p0[0] * cs[0][1]; v0[1] = v0[1] * cs[0][2] + sgn * p0[1] * cs[0][3];
                            v0[2] = v0[2] * cs[1][0] + sgn * p0[2] * cs[1][1]; v0[3] = v0[3] * cs[1][2] + sgn * p0[3] * cs[1][3];
                            v1[0] = v1[0] * cs[2][0] + sgn * p1[0] * cs[2][1]; v1[1] = v1[1] * cs[2][2] + sgn * p1[1] * cs[2][3];
                            v1[2] = v1[2] * cs[3][0] + sgn * p1[2] * cs[3][1]; v1[3] = v1[3] * cs[3][2] + sgn * p1[3] * cs[3][3];
                        }
                    }
                    v0 = v0 * sc; v1 = v1 * sc;
                    u32x4 w; w.x = cvt_pk_bf16(v0[0], v0[1]); w.y = cvt_pk_bf16(v0[2], v0[3]); w.z = cvt_pk_bf16(v1[0], v1[1]); w.w = cvt_pk_bf16(v1[2], v1[3]);
                    *(u32x4*)(rowp + bj * HALF) = w;
                }
            }
    }
};
template <bool BF16OUT> struct EpiResid {
    static constexpr bool PERM = false;
    const float* res; float* out; bf16_t* ob; float* ssq;
    __device__ __forceinline__ void operator()(const f32x4 (&acc)[2][2][4][2], const Unit& u, int wr, int wc, int fr, int fq) const {
        const int row0 = u.pm * BM + wr * 64 + fr, col0 = u.pn * BM + wc * 32 + 4 * fq;
#pragma unroll
        for (int ai = 0; ai < 2; ++ai)
#pragma unroll
            for (int m = 0; m < 4; ++m) {
                const int row = row0 + ai * HALF + m * 16; const size_t off = (size_t)row * 1024 + col0; float ss = 0.f;
#pragma unroll
                for (int bj = 0; bj < 2; ++bj)
#pragma unroll
                    for (int n = 0; n < 2; ++n) {
                        const size_t o = off + bj * HALF + n * 16;
                        const f32x4 v = acc[ai][bj][m][n] + *(const f32x4*)(res + o);
                        *(f32x4*)(out + o) = v; ss += (v[0] * v[0] + v[1] * v[1]) + (v[2] * v[2] + v[3] * v[3]);
                        if (BF16OUT) { u32x2 w; w.x = cvt_pk_bf16(v[0], v[1]); w.y = cvt_pk_bf16(v[2], v[3]); *(u32x2*)(ob + o) = w; }
                    }
                ss += __shfl_xor(ss, 16); ss += __shfl_xor(ss, 32);
                if (fq == 0) ssq[(size_t)row * 16 + u.pn * 4 + wc] = ss;
            }
    }
};
template <bool RSTD> struct EpiSwiGLU {
    static constexpr bool PERM = true;
    bf16_t* O; int ldc; const float* ssq;
    __device__ __forceinline__ void operator()(const f32x4 (&acc)[2][2][4][2], const Unit& u, int wr, int wc, int fr, int fq) const {
        const int row0 = u.pm * BM + wr * 64 + fr, col0 = u.pn * HALF + wc * 32 + 8 * fq;
#pragma unroll
        for (int ai = 0; ai < 2; ++ai)
#pragma unroll
            for (int m = 0; m < 4; ++m) {
                const int row = row0 + ai * HALF + m * 16; float rs = 1.f;
                if (RSTD) { const f32x4* sp = (const f32x4*)(ssq + (size_t)row * 16); const f32x4 a = sp[0], b = sp[1], c = sp[2], d = sp[3];
                    const f32x4 t = (a + b) + (c + d); rs = __builtin_amdgcn_rsqf(((t[0] + t[1]) + (t[2] + t[3])) * (1.0f / 1024.0f) + 1e-6f); }
                float h[8];
#pragma unroll
                for (int n = 0; n < 2; ++n)
#pragma unroll
                    for (int j = 0; j < 4; ++j) { const float g = acc[ai][0][m][n][j] * rs, up = acc[ai][1][m][n][j] * rs;
                        h[n * 4 + j] = g * __builtin_amdgcn_rcpf(1.0f + __expf(-g)) * up; }
                u32x4 w; w.x = cvt_pk_bf16(h[0], h[1]); w.y = cvt_pk_bf16(h[2], h[3]); w.z = cvt_pk_bf16(h[4], h[5]); w.w = cvt_pk_bf16(h[6], h[7]);
                *(u32x4*)(O + (size_t)row * ldc + col0) = w;
            }
    }
};
struct EpiPool {
    static constexpr bool PERM = false;
    float* H; const float* scale;
    __device__ __forceinline__ void operator()(const f32x4 (&acc)[2][2][4][2], const Unit& u, int wr, int wc, int fr, int fq) const {
        const int row0 = u.pm * BM + wr * 64 + fr, col0 = u.pn * BM + wc * 32 + 4 * fq;
        f32x4 sv[2][2];
#pragma unroll
        for (int bj = 0; bj < 2; ++bj)
#pragma unroll
            for (int n = 0; n < 2; ++n) sv[bj][n] = *(const f32x4*)(scale + col0 + bj * HALF + n * 16);
#pragma unroll
        for (int ai = 0; ai < 2; ++ai)
#pragma unroll
            for (int m = 0; m < 4; ++m) {
                const size_t off = (size_t)(row0 + ai * HALF + m * 16) * 1024 + col0;
#pragma unroll
                for (int bj = 0; bj < 2; ++bj)
#pragma unroll
                    for (int n = 0; n < 2; ++n) { const size_t o = off + bj * HALF + n * 16; *(f32x4*)(H + o) = *(const f32x4*)(H + o) + acc[ai][bj][m][n] * sv[bj][n]; }
            }
    }
};
struct EpiScatter {
    static constexpr bool PERM = true;
    bf16_t* Y; const int* slot; const float* gate; int pm0;
    __device__ __forceinline__ void operator()(const f32x4 (&acc)[2][2][4][2], const Unit& u, int wr, int wc, int fr, int fq) const {
        const int pos0 = (pm0 + u.pm) * BM + wr * 64 + fr, col0 = u.pn * BM + wc * 32 + 8 * fq;
#pragma unroll
        for (int ai = 0; ai < 2; ++ai)
#pragma unroll
            for (int m = 0; m < 4; ++m) {
                const int pos = pos0 + ai * HALF + m * 16; const int s = slot[pos]; const float g = gate[pos];
                if (s >= 0) {
#pragma unroll
                    for (int bj = 0; bj < 2; ++bj) { const f32x4 v0 = acc[ai][bj][m][0] * g, v1 = acc[ai][bj][m][1] * g;
                        u32x4 w; w.x = cvt_pk_bf16(v0[0], v0[1]); w.y = cvt_pk_bf16(v0[2], v0[3]); w.z = cvt_pk_bf16(v1[0], v1[1]); w.w = cvt_pk_bf16(v1[2], v1[3]);
                        *(u32x4*)(Y + (size_t)s * 1024 + col0 + bj * HALF) = w; }
                }
            }
    }
};

template <class Epi, bool GATHER, bool ALIGN_EPI>
__device__ __forceinline__ void gemm_phase2(PG8_LAS unsigned char* lds, const GSched& S, const int K, const int lda, const int ldb, const Epi& E) {
    int tid_ = threadIdx.x; asm volatile("" : "+v"(tid_));
    const int tid = tid_, wid = __builtin_amdgcn_readfirstlane(tid >> 6), lane = tid & 63, wr = wid >> 2, wc = wid & 3, fr = lane & 15, fq = lane >> 4;
    const int nt = K / BK;
    int Rr[2], Cc[2]; unsigned voffB[2], voA[2][2], nvoA[2][2];
#pragma unroll
    for (int i = 0; i < 2; ++i) { stage_rc(tid * 16 + i * 8192, Rr[i], Cc[i]); const int Rb = Epi::PERM ? ((Rr[i] & ~31) + perm32(Rr[i] & 31)) : Rr[i];
        voffB[i] = (unsigned)(Rb * ldb + Cc[i]) * 2u;
#pragma unroll
        for (int h = 0; h < 2; ++h) { voA[h][i] = (unsigned)((Rr[i] + h * HALF) * lda + Cc[i]) * 2u; nvoA[h][i] = voA[h][i]; } }
    const size_t kstep = (size_t)(BK * 2);
    const size_t hstepB = (size_t)HALF * ldb * 2;
    const unsigned ldsw = (unsigned)wid * 1024u;
    const int aoff = lds_byte(wr * 64 + fr, fq * 8), boff = lds_byte(wc * 32 + fr, fq * 8);
#define PG8_SA(b, h) (((b) * 2 + (h)) * HTB)
#define PG8_SB(b, h) ((4 + (b) * 2 + (h)) * HTB)
#define PG8_STAGE(bufoff, gbase, voff) do { _Pragma("unroll") for (int _i = 0; _i < 2; ++_i) \
        __builtin_amdgcn_global_load_lds((const unsigned*)((const char*)(gbase) + (voff)[_i]), (PG8_LAS unsigned*)(lds + (bufoff) + ldsw + _i * 8192), 16, 0, 0); } while (0)
#define PG8_LDA(dst, b, h) do { _Pragma("unroll") for (int m = 0; m < 4; ++m) _Pragma("unroll") for (int k = 0; k < 2; ++k) dst[m][k] = *(const PG8_LAS bf16x8*)(lds + PG8_SA(b, h) + aoff + m * 2048 + k * 1024); } while (0)
#define PG8_LDB(dst, b, h) do { _Pragma("unroll") for (int n = 0; n < 2; ++n) _Pragma("unroll") for (int k = 0; k < 2; ++k) dst[n][k] = *(const PG8_LAS bf16x8*)(lds + PG8_SB(b, h) + boff + n * 2048 + k * 1024); } while (0)
#define PG8_MMA(ai, bj, At, Bt) do { __builtin_amdgcn_s_setprio(1); _Pragma("unroll") for (int m = 0; m < 4; ++m) _Pragma("unroll") for (int n = 0; n < 2; ++n) _Pragma("unroll") for (int k = 0; k < 2; ++k) \
        acc[ai][bj][m][n] = __builtin_amdgcn_mfma_f32_16x16x32_bf16(Bt[n][k], At[m][k], acc[ai][bj][m][n], 0, 0, 0); __builtin_amdgcn_s_setprio(0); } while (0)
#define PG8_WAIT_V(n) asm volatile("s_waitcnt vmcnt(" #n ")" ::: "memory")
#define PG8_WAIT_L(n) asm volatile("s_waitcnt lgkmcnt(" #n ")" ::: "memory")
#define PG8_BAR __builtin_amdgcn_s_barrier()
#define PG8_SCHED __builtin_amdgcn_sched_barrier(0)
#define PG8_GIDX(dst, u) do { if constexpr (GATHER) { _Pragma("unroll") for (int _h = 0; _h < 2; ++_h) _Pragma("unroll") for (int _i = 0; _i < 2; ++_i) \
        dst[_h][_i] = (unsigned)S.rowidx[(S.pm0 + (u).pm) * BM + _h * HALF + Rr[_i]] * (unsigned)(lda * 2) + (unsigned)(Cc[_i] * 2); } } while (0)
    Unit cur, nxt; int ui = 0;
    if (!S.next(0, cur)) return;
    f32x4 acc[2][2][4][2];
#pragma unroll
    for (int a = 0; a < 2; ++a)
#pragma unroll
        for (int b = 0; b < 2; ++b)
#pragma unroll
            for (int m = 0; m < 4; ++m)
#pragma unroll
                for (int n = 0; n < 2; ++n) acc[a][b][m][n] = (f32x4){0.f, 0.f, 0.f, 0.f};
    bf16x8 At[4][2], B0[2][2], B1[2][2];
    const char* cA = S.a_ptr(cur); const char* cB = S.b_ptr(cur);
    PG8_GIDX(voA, cur);
    PG8_STAGE(PG8_SB(0, 0), cB, voffB); PG8_STAGE(PG8_SB(0, 1), cB + hstepB, voffB); PG8_STAGE(PG8_SA(0, 0), cA, voA[0]); PG8_STAGE(PG8_SA(0, 1), cA, voA[1]);
    if (wr == 1) PG8_BAR;
    PG8_WAIT_V(2); PG8_BAR;
    PG8_STAGE(PG8_SB(1, 0), cB + kstep, voffB); PG8_STAGE(PG8_SA(1, 0), cA + kstep, voA[0]); PG8_STAGE(PG8_SB(1, 1), cB + hstepB + kstep, voffB);
    PG8_WAIT_V(6); PG8_BAR;
    for (;;) {
        const bool has_next = S.next(ui + 1, nxt);
        const char* nA = has_next ? S.a_ptr(nxt) : cA; const char* nB = has_next ? S.b_ptr(nxt) : cB;
        if constexpr (GATHER) { if (has_next) { PG8_GIDX(nvoA, nxt); } else {
#pragma unroll
            for (int h = 0; h < 2; ++h)
#pragma unroll
                for (int i = 0; i < 2; ++i) nvoA[h][i] = voA[h][i]; } }
        for (int t = 0; t < nt; t += 2) {
            const bool last = (t == nt - 2);
            const char* a1 = cA + (size_t)(t + 1) * kstep;
            const char* a2 = last ? nA : cA + (size_t)(t + 2) * kstep; const char* b2 = last ? nB : cB + (size_t)(t + 2) * kstep;
            const char* a3 = a2 + kstep; const char* b3 = b2 + kstep;
            unsigned v2[2][2];
#pragma unroll
            for (int h = 0; h < 2; ++h)
#pragma unroll
                for (int i = 0; i < 2; ++i) v2[h][i] = (GATHER && last) ? nvoA[h][i] : voA[h][i];
            PG8_LDB(B0, 0, 0); PG8_LDB(B1, 0, 1); PG8_SCHED; PG8_LDA(At, 0, 0); PG8_STAGE(PG8_SA(1, 1), a1, voA[1]);
            PG8_WAIT_V(8); PG8_WAIT_L(0); PG8_BAR; PG8_MMA(0, 0, At, B0); PG8_MMA(0, 1, At, B1); PG8_BAR; PG8_SCHED;
            PG8_LDA(At, 0, 1); PG8_STAGE(PG8_SB(0, 0), b2, voffB); PG8_STAGE(PG8_SB(0, 1), b2 + hstepB, voffB); PG8_STAGE(PG8_SA(0, 0), a2, v2[0]);
            PG8_WAIT_V(8); PG8_WAIT_L(0); PG8_BAR; PG8_MMA(1, 0, At, B0); PG8_MMA(1, 1, At, B1); PG8_BAR; PG8_SCHED;
            PG8_LDB(B0, 1, 0); PG8_LDB(B1, 1, 1); PG8_SCHED; PG8_LDA(At, 1, 0); PG8_STAGE(PG8_SA(0, 1), a2, v2[1]);
            PG8_WAIT_V(8); PG8_WAIT_L(0); PG8_BAR; PG8_MMA(0, 0, At, B0); PG8_MMA(0, 1, At, B1); PG8_BAR; PG8_SCHED;
            PG8_LDA(At, 1, 1); PG8_STAGE(PG8_SB(1, 0), b3, voffB); PG8_STAGE(PG8_SB(1, 1), b3 + hstepB, voffB); PG8_STAGE(PG8_SA(1, 0), a3, v2[0]);
            PG8_WAIT_V(8); PG8_WAIT_L(0); PG8_BAR; PG8_MMA(1, 0, At, B0); PG8_MMA(1, 1, At, B1); PG8_BAR; PG8_SCHED;
        }
        if constexpr (ALIGN_EPI) { if (wr == 0) PG8_BAR; }
        E(acc, cur, wr, wc, fr, fq);
        if (!has_next) break;
#pragma unroll
        for (int a = 0; a < 2; ++a)
#pragma unroll
            for (int b = 0; b < 2; ++b)
#pragma unroll
                for (int m = 0; m < 4; ++m)
#pragma unroll
                    for (int n = 0; n < 2; ++n) acc[a][b][m][n] = (f32x4){0.f, 0.f, 0.f, 0.f};
        cur = nxt; cA = nA; cB = nB; ++ui;
        if constexpr (GATHER) {
#pragma unroll
            for (int h = 0; h < 2; ++h)
#pragma unroll
                for (int i = 0; i < 2; ++i) voA[h][i] = nvoA[h][i]; }
        if constexpr (ALIGN_EPI) { if (wr == 1) PG8_BAR; }
    }
    PG8_WAIT_V(0);
    if constexpr (!ALIGN_EPI) { if (wr == 0) PG8_BAR; }
    PG8_BAR;
#undef PG8_SA
#undef PG8_SB
#undef PG8_STAGE
#undef PG8_LDA
#undef PG8_LDB
#undef PG8_MMA
#undef PG8_WAIT_V
#undef PG8_WAIT_L
#undef PG8_BAR
#undef PG8_SCHED
#undef PG8_GIDX
}
}
namespace attn_body {
using bf16=__hip_bfloat16;
using bf16x8=__attribute__((ext_vector_type(8)))short;
using s16x4=__attribute__((ext_vector_type(4)))short;
using f32x16=__attribute__((ext_vector_type(16)))float;
using u32x4=__attribute__((ext_vector_type(4)))unsigned;
constexpr int SEQ=4096,D=64,PQ=2560,PO=1024;
constexpr int NW=8,QBLK=32,QB=QBLK*NW,KVBLK=64,NQB=SEQ/QB;
constexpr int ATTN_UNIT_ROWS=QB;
__device__ __forceinline__ int crow(int r,int hi){return (r&3)+8*(r>>2)+4*hi;}
#define SBAR() __builtin_amdgcn_sched_barrier(0)
__device__ __forceinline__ void cmask(f32x16&p0,f32x16&p1,int jb,int qrel,int hi){
  const float NEG=-INFINITY; int kb=64*jb+4*hi;
  #pragma unroll
  for(int r=0;r<16;++r){int kv=kb+(r&3)+8*(r>>2); if(kv>qrel)p0[r]=NEG; if(kv+32>qrel)p1[r]=NEG;}
}

constexpr int NSLOT=3, SLOTB=8192;
constexpr int LDS_K=0, LDS_V=NSLOT*SLOTB, LDS_WS=2*NSLOT*SLOTB, LDS_OST=LDS_WS+NW*64*4, LDS_BYTES=LDS_OST+NW*4096;
constexpr float C2=0.125f*1.4426950408889634f;
__device__ __forceinline__ void glds16(const void*gsrc,unsigned lds_dst){unsigned keep;
  asm volatile("s_mov_b32 %0, m0\n\ts_mov_b32 m0, %2\n\ts_nop 0\n\tglobal_load_lds_dwordx4 %1, off\n\ts_mov_b32 m0, %0":"=&s"(keep):"v"(gsrc),"s"(lds_dst):"memory");}
__device__ __forceinline__ float max3f(float a,float b,float c){float r;asm("v_max3_f32 %0, %1, %2, %3":"=v"(r):"v"(a),"v"(b),"v"(c));return r;}
__device__ __forceinline__ float max2f(float a,float b){float r;asm("v_max_f32_e32 %0, %1, %2":"=v"(r):"v"(a),"v"(b));return r;}
__device__ __forceinline__ float fadd_s(float a,float b){float r;asm("v_add_f32_e32 %0, %1, %2":"=v"(r):"v"(a),"v"(b));return r;}
__device__ __forceinline__ float fsub_s(float a,float b){float r;asm("v_sub_f32_e32 %0, %1, %2":"=v"(r):"v"(a),"v"(b));return r;}
typedef float f32x2_t __attribute__((ext_vector_type(2))); typedef __bf16 bf16x2_t __attribute__((ext_vector_type(2)));
__device__ __forceinline__ unsigned cvtpk_s(float lo,float hi){f32x2_t v={lo,hi};bf16x2_t b=__builtin_convertvector(v,bf16x2_t);return __builtin_bit_cast(unsigned,b);}
#define WAIT_BAR(N) asm volatile("s_waitcnt vmcnt(" #N ") lgkmcnt(0)\n\ts_barrier":::"memory")

__device__ __forceinline__ void qkt(f32x16&p0,f32x16&p1,const char*Kslot,const bf16x8*qr,const f32x16&negm,int r32,int hi){
  const char*kb=Kslot+hi*1024+r32*16;
  #pragma unroll
  for(int d0=0;d0<4;++d0){
    const bf16x8 b0=*reinterpret_cast<const bf16x8*>(kb+d0*2048);
    const bf16x8 b1=*reinterpret_cast<const bf16x8*>(kb+d0*2048+512);
    if(d0==0){p0=__builtin_amdgcn_mfma_f32_32x32x16_bf16(b0,qr[0],negm,0,0,0);p1=__builtin_amdgcn_mfma_f32_32x32x16_bf16(b1,qr[0],negm,0,0,0);}
    else{p0=__builtin_amdgcn_mfma_f32_32x32x16_bf16(b0,qr[d0],p0,0,0,0);p1=__builtin_amdgcn_mfma_f32_32x32x16_bf16(b1,qr[d0],p1,0,0,0);}}
}
typedef __attribute__((address_space(3))) const char* lds_cptr;
typedef short v4i16_t __attribute__((ext_vector_type(4)));
__device__ __forceinline__ void kload8(bf16x8*kf,lds_cptr kp){
  kf[0]=*(const __attribute__((address_space(3))) bf16x8*)(kp);      kf[1]=*(const __attribute__((address_space(3))) bf16x8*)(kp+512);
  kf[2]=*(const __attribute__((address_space(3))) bf16x8*)(kp+2048); kf[3]=*(const __attribute__((address_space(3))) bf16x8*)(kp+2560);
  kf[4]=*(const __attribute__((address_space(3))) bf16x8*)(kp+4096); kf[5]=*(const __attribute__((address_space(3))) bf16x8*)(kp+4608);
  kf[6]=*(const __attribute__((address_space(3))) bf16x8*)(kp+6144); kf[7]=*(const __attribute__((address_space(3))) bf16x8*)(kp+6656);
}
__device__ __forceinline__ void kload2(bf16x8*kf,lds_cptr kp,int j){ kf[2*j]=*(const __attribute__((address_space(3))) bf16x8*)(kp+j*2048); kf[2*j+1]=*(const __attribute__((address_space(3))) bf16x8*)(kp+j*2048+512); }
__device__ __forceinline__ s16x4 vtr(lds_cptr p){ return __builtin_bit_cast(s16x4,__builtin_amdgcn_ds_read_tr16_b64_v4i16((__attribute__((address_space(3))) v4i16_t*)p)); }
__device__ __forceinline__ float rowmax(const f32x16&p0,const f32x16&p1){
  float a=max3f(p0[0],p0[1],p1[0]),b=max3f(p0[2],p0[3],p1[1]);a=max3f(a,p1[2],p1[3]);
  #pragma unroll
  for(int r=4;r<16;r+=4){a=max3f(a,p0[r],p0[r+1]);b=max3f(b,p0[r+2],p0[r+3]);a=max3f(a,p1[r],p1[r+1]);b=max3f(b,p1[r+2],p1[r+3]);}
  const float m=max2f(a,b);
  auto rr=__builtin_amdgcn_permlane32_swap(__float_as_uint(m),__float_as_uint(m),false,false);
  return max2f(__uint_as_float(rr[0]),__uint_as_float(rr[1]));
}
__device__ __forceinline__ void pv(f32x16*o,int vb,bf16x8 pa0,bf16x8 pa1,bf16x8 pa2,bf16x8 pa3){
  #pragma unroll
  for(int d0=0;d0<2;++d0){s16x4 lo[4],hi[4];
    #pragma unroll
    for(int ks=0;ks<4;++ks){
      asm volatile("ds_read_b64_tr_b16 %0,%1 offset:%c2":"=&v"(lo[ks]):"v"(vb),"i"(d0*4096+ks*1024):"memory");
      asm volatile("ds_read_b64_tr_b16 %0,%1 offset:%c2":"=&v"(hi[ks]):"v"(vb),"i"(d0*4096+ks*1024+512):"memory");}
    asm volatile("s_waitcnt lgkmcnt(0)":::"memory");SBAR();
    #define PK(k) (bf16x8){lo[k][0],lo[k][1],lo[k][2],lo[k][3],hi[k][0],hi[k][1],hi[k][2],hi[k][3]}
    o[d0]=__builtin_amdgcn_mfma_f32_32x32x16_bf16(pa0,PK(0),o[d0],0,0,0);
    o[d0]=__builtin_amdgcn_mfma_f32_32x32x16_bf16(pa1,PK(1),o[d0],0,0,0);
    o[d0]=__builtin_amdgcn_mfma_f32_32x32x16_bf16(pa2,PK(2),o[d0],0,0,0);
    o[d0]=__builtin_amdgcn_mfma_f32_32x32x16_bf16(pa3,PK(3),o[d0],0,0,0);
    #undef PK
  }
}

#ifndef ATTN_STORE16
#define ATTN_STORE16(p,v) (*(u32x4*)(p)=(v))
#endif
template<int THRL> __device__ __forceinline__ void attn_unit(int b,int qb,const bf16*Q,const bf16*__restrict__ K,const bf16*__restrict__ V,bf16*O,char*shm){
  const int tid=threadIdx.x,lane=tid&63,r32=lane&31,hi=lane>>5; const int wid=__builtin_amdgcn_readfirstlane(tid>>6);
  const long rowbase=(long)b*SEQ; const int q0=qb*QB;
  const bf16*Qw=Q+(rowbase+q0+wid*QBLK)*PQ;
  const bf16*Kh=K+rowbase*PQ,*Vh=V+rowbase*PQ;
  const unsigned lds0=(unsigned)(uintptr_t)shm;
  float*wsf=(float*)(shm+LDS_WS)+wid*64;
  const bf16*ksrc=Kh+(long)lane*PQ+wid*8;
  const bf16*vsrc=Vh+(long)(16*(wid&3)+(lane>>2))*PQ+(wid>>2)*32+(lane&3)*8;
  const unsigned kdst=lds0+LDS_K+wid*1024, vdst=lds0+LDS_V+wid*1024;
  #define DMA_K(t,slot) glds16(ksrc+(long)(t)*KVBLK*PQ,(unsigned)__builtin_amdgcn_readfirstlane(kdst+(slot)))
  #define DMA_V(t,slot) glds16(vsrc+(long)(t)*KVBLK*PQ,(unsigned)__builtin_amdgcn_readfirstlane(vdst+(slot)))
  const int vb0=(int)(lds0+LDS_V)+((lane>>4)&1)*32+(lane&3)*8+(4*hi+((lane&15)>>2))*64;
  const char*Kbase=shm+LDS_K; bf16x8 kf[8];
  const lds_cptr shm3=(lds_cptr)shm; const lds_cptr kp0=shm3+LDS_K+hi*1024+r32*16; const lds_cptr vp0=shm3+LDS_V+((lane>>4)&1)*32+(lane&3)*8+(4*hi+((lane&15)>>2))*64;
  const int NT=(q0+QB)/KVBLK;
  DMA_K(0,0);DMA_V(0,0);DMA_K(1,SLOTB);
  bf16x8 qr[4];
  #pragma unroll
  for(int d0=0;d0<4;++d0)qr[d0]=*reinterpret_cast<const bf16x8*>(&Qw[(long)r32*PQ+d0*16+hi*8]);
  float mhat=0.f,l_reg=0.f;f32x16 o[2];o[0]=f32x16{};o[1]=f32x16{};f32x16 negm=f32x16{};asm volatile("":"+v"(negm));
  const int qrel=wid*QBLK+r32;
  #define CMASK(P0,P1,t) do{int jb_=(t)-(NT-4); if(jb_>=0)cmask(P0,P1,jb_,qrel,hi);}while(0)
  bool resc=false;
  #define START(P0,P1) do{ const float rm=rowmax(P0,P1); resc=false; \
    { const float dl=rm; mhat=fadd_s(mhat,dl); \
      _Pragma("unroll") for(int r=0;r<16;++r){P0[r]=fsub_s(P0[r],dl);P1[r]=fsub_s(P1[r],dl);} \
      _Pragma("unroll") for(int r=0;r<16;++r)negm[r]=-mhat; asm volatile("":"+v"(negm)); } \
    _Pragma("unroll") for(int r=0;r<16;++r)P0[r]=__builtin_amdgcn_exp2f(P0[r]); }while(0)
  #define RESC() do{ if(resc){ asm volatile("s_waitcnt lgkmcnt(0)":::"memory"); \
      _Pragma("unroll") for(int d_=0;d_<2;++d_) _Pragma("unroll") for(int r=0;r<16;++r)o[d_][r]*=wsf[crow(r,hi)]; } }while(0)
  f32x16 pA0,pA1,pB0,pB1;
  int sl_prev=0,sl_cur=0,sl_next=SLOTB;
  #define ROT() do{sl_prev=sl_cur;sl_cur=sl_next;sl_next=(sl_next==(NSLOT-1)*SLOTB)?0:sl_next+SLOTB;}while(0)
  DMA_K(2,2*SLOTB);
  WAIT_BAR(3);
  qkt(pA0,pA1,Kbase,qr,negm,r32,hi);asm volatile("s_nop 15\n\ts_nop 7":"+v"(pA0),"+v"(pA1));CMASK(pA0,pA1,0);
  START(pA0,pA1);
  _Pragma("unroll") for(int r=0;r<16;++r)pA1[r]=__builtin_amdgcn_exp2f(pA1[r]);
  WAIT_BAR(0);
  DMA_K(3,0);DMA_V(1,SLOTB);
  ROT();
  kload8(kf,kp0+sl_cur);
  WAIT_BAR(2);
  s16x4 vlo[8],vhi[8]; u32x4 pw0,pw1,pw2,pw3;
  #define PKW(P,B) cvtpk_s(P[B],P[B+1])
  #define PAF(k) __builtin_bit_cast(bf16x8,pw##k)
  #define VFR(i) (bf16x8){vlo[i][0],vlo[i][1],vlo[i][2],vlo[i][3],vhi[i][0],vhi[i][1],vhi[i][2],vhi[i][3]}
  #define PIN(x) asm volatile("":"+v"(x))
  #define MX3(a,b,c) __builtin_fmaxf(__builtin_fmaxf((a),(b)),(c))
  #define GAPA(MF,A0,A1,A2,A3,W0,W1,PW) do{ MF; sacc+=A0; sacc+=A1; sacc+=A2; sacc+=A3; PIN(sacc); W0; W1; PIN(PW); SBAR(); }while(0)
  #define EX(v) __builtin_amdgcn_exp2f(v)
  #define GAPB(MF,X,B) do{ MF; X[B]=EX(X[B]); X[B+1]=EX(X[B+1]); X[B+2]=EX(X[B+2]); X[B+3]=EX(X[B+3]); PIN(X); SBAR(); }while(0)
  #define VRD(i) do{ vlo[i]=vtr(vp_+(((i)>>2)*4096+((i)&3)*1024)); vhi[i]=vtr(vp_+(((i)>>2)*4096+((i)&3)*1024+512)); }while(0)
  #define KRD(G,j) do{ if(G){ kload2(kf,kp0+sl_next,j); SBAR(); } }while(0)
  #define STEP(C0,C1,P0,P1,t,GK,GV,GL) do{ SBAR(); \
    const lds_cptr vp_=vp0+sl_prev; \
    VRD(0); SBAR(); float sacc=(P0[0]+P0[1]); \
    GAPA(C0=__builtin_amdgcn_mfma_f32_32x32x16_bf16(kf[0],qr[0],negm,0,0,0), P0[2],P0[3],P0[4],P0[5],     pw0[0]=PKW(P0,0), pw0[1]=PKW(P0,2), pw0); \
    VRD(4); SBAR(); GAPA(C1=__builtin_amdgcn_mfma_f32_32x32x16_bf16(kf[1],qr[0],negm,0,0,0), P0[6],P0[7],P0[8],P0[9],     pw0[2]=PKW(P0,4), pw0[3]=PKW(P0,6), pw0); \
    VRD(1); SBAR(); GAPA(C0=__builtin_amdgcn_mfma_f32_32x32x16_bf16(kf[2],qr[1],C0,0,0,0),   P0[10],P0[11],P0[12],P0[13], pw1[0]=PKW(P0,8), pw1[1]=PKW(P0,10), pw1); \
    VRD(5); SBAR(); GAPA(C1=__builtin_amdgcn_mfma_f32_32x32x16_bf16(kf[3],qr[1],C1,0,0,0),   P0[14],P0[15],P1[0],P1[1],   pw1[2]=PKW(P0,12),pw1[3]=PKW(P0,14), pw1); \
    VRD(2); SBAR(); GAPA(C0=__builtin_amdgcn_mfma_f32_32x32x16_bf16(kf[4],qr[2],C0,0,0,0),   P1[2],P1[3],P1[4],P1[5],     pw2[0]=PKW(P1,0), pw2[1]=PKW(P1,2), pw2); \
    VRD(6); SBAR(); GAPA(C1=__builtin_amdgcn_mfma_f32_32x32x16_bf16(kf[5],qr[2],C1,0,0,0),   P1[6],P1[7],P1[8],P1[9],     pw2[2]=PKW(P1,4), pw2[3]=PKW(P1,6), pw2); \
    VRD(3); SBAR(); GAPA(C0=__builtin_amdgcn_mfma_f32_32x32x16_bf16(kf[6],qr[3],C0,0,0,0),   P1[10],P1[11],P1[12],P1[13], pw3[0]=PKW(P1,8), pw3[1]=PKW(P1,10), pw3); \
    VRD(7); SBAR(); GAPA(C1=__builtin_amdgcn_mfma_f32_32x32x16_bf16(kf[7],qr[3],C1,0,0,0),   P1[14],P1[15],0.f,0.f,       pw3[2]=PKW(P1,12),pw3[3]=PKW(P1,14), pw3); \
    l_reg+=sacc; \
    if(GK){DMA_K((t)+3,sl_cur);} if(GV){DMA_V((t)+1,sl_next);} \
    CMASK(C0,C1,t); \
    { float a=MX3(C0[0],C0[1],C1[0]),b=MX3(C0[2],C0[3],C1[1]); a=MX3(a,C1[2],C1[3]); \
      _Pragma("unroll") for(int r=4;r<16;r+=4){a=MX3(a,C0[r],C0[r+1]);b=MX3(b,C0[r+2],C0[r+3]);a=MX3(a,C1[r],C1[r+1]);b=MX3(b,C1[r+2],C1[r+3]);} \
      float rm=__builtin_fmaxf(a,b); { auto rr=__builtin_amdgcn_permlane32_swap(__float_as_uint(rm),__float_as_uint(rm),false,false); rm=__builtin_fmaxf(__uint_as_float(rr[0]),__uint_as_float(rr[1])); } \
      resc=false; \
      if(__builtin_expect(__any(rm>(float)THRL),0)){ const float dl=__builtin_fmaxf(rm,0.f); mhat+=dl; \
        _Pragma("unroll") for(int r=0;r<16;++r){C0[r]-=dl;C1[r]-=dl;} \
        _Pragma("unroll") for(int r=0;r<16;++r)negm[r]=-mhat; asm volatile("":"+v"(negm)); \
        const float f=__builtin_amdgcn_exp2f(-dl); l_reg*=f; if(hi==0)wsf[r32]=f; resc=true; } } \
    SBAR(); \
    GAPB(o[0]=__builtin_amdgcn_mfma_f32_32x32x16_bf16(PAF(0),VFR(0),o[0],0,0,0), C0,0); \
    GAPB(o[1]=__builtin_amdgcn_mfma_f32_32x32x16_bf16(PAF(0),VFR(4),o[1],0,0,0), C0,4); \
    KRD(GL,0); GAPB(o[0]=__builtin_amdgcn_mfma_f32_32x32x16_bf16(PAF(1),VFR(1),o[0],0,0,0), C0,8); \
    KRD(GL,1); GAPB(o[1]=__builtin_amdgcn_mfma_f32_32x32x16_bf16(PAF(1),VFR(5),o[1],0,0,0), C0,12); \
    KRD(GL,2); GAPB(o[0]=__builtin_amdgcn_mfma_f32_32x32x16_bf16(PAF(2),VFR(2),o[0],0,0,0), C1,0); \
    KRD(GL,3); GAPB(o[1]=__builtin_amdgcn_mfma_f32_32x32x16_bf16(PAF(2),VFR(6),o[1],0,0,0), C1,4); \
    GAPB(o[0]=__builtin_amdgcn_mfma_f32_32x32x16_bf16(PAF(3),VFR(3),o[0],0,0,0), C1,8); \
    GAPB(o[1]=__builtin_amdgcn_mfma_f32_32x32x16_bf16(PAF(3),VFR(7),o[1],0,0,0), C1,12); \
    }while(0)
  int t=1;
  #undef CMASK
  #define CMASK(P0,P1,t) do{}while(0)
  for(;t+5<NT;t+=2){
    STEP(pB0,pB1,pA0,pA1,t,true,true,true);     WAIT_BAR(2); RESC(); ROT();
    STEP(pA0,pA1,pB0,pB1,t+1,true,true,true);   WAIT_BAR(2); RESC(); ROT();
  }
  #undef CMASK
  #define CMASK(P0,P1,t) do{int jb_=(t)-(NT-4); if(jb_>=0)cmask(P0,P1,jb_,qrel,hi);}while(0)
  #define ENDW(tt) do{ if((tt)+3<NT){WAIT_BAR(2);} else if((tt)+2<NT){WAIT_BAR(1);} else {WAIT_BAR(0);} }while(0)
  for(;t+1<NT;t+=2){
    STEP(pB0,pB1,pA0,pA1,t,(t+3<NT),(t+1<NT),(t+1<NT));       ENDW(t);   RESC(); ROT();
    STEP(pA0,pA1,pB0,pB1,t+1,(t+4<NT),(t+2<NT),(t+2<NT));     ENDW(t+1); RESC(); ROT();
  }
  STEP(pB0,pB1,pA0,pA1,NT-1,false,false,false); RESC();
  { float sacc=pB0[0]+pB0[1]; _Pragma("unroll") for(int r=2;r<16;++r)sacc+=pB0[r]; _Pragma("unroll") for(int r=0;r<16;++r)sacc+=pB1[r]; l_reg+=sacc;
    pw0=(u32x4){PKW(pB0,0),PKW(pB0,2),PKW(pB0,4),PKW(pB0,6)};pw1=(u32x4){PKW(pB0,8),PKW(pB0,10),PKW(pB0,12),PKW(pB0,14)};pw2=(u32x4){PKW(pB1,0),PKW(pB1,2),PKW(pB1,4),PKW(pB1,6)};pw3=(u32x4){PKW(pB1,8),PKW(pB1,10),PKW(pB1,12),PKW(pB1,14)};
    SBAR(); pv(o,vb0+sl_cur,PAF(0),PAF(1),PAF(2),PAF(3)); }
  #undef PKW
  #undef PAF
  #undef VFR
  #undef PIN
  #undef MX3
  #undef GAPA
  #undef GAPB
  #undef EX
  #undef VRD
  #undef KRD
  #undef STEP
  #undef ENDW
  {auto rr=__builtin_amdgcn_permlane32_swap(__float_as_uint(l_reg),__float_as_uint(l_reg),false,false);l_reg=__uint_as_float(rr[0])+__uint_as_float(rr[1]);}
  if(hi==0)wsf[32+r32]=l_reg;asm volatile("s_waitcnt lgkmcnt(0)":::"memory");
  float rli[16];
  #pragma unroll
  for(int r=0;r<16;++r)rli[r]=__builtin_amdgcn_rcpf(wsf[32+crow(r,hi)]);
  bf16*Ow=O+(rowbase+q0+wid*QBLK)*PO;
  { bf16*stg=(bf16*)(shm+LDS_OST)+wid*2048;
    #pragma unroll
    for(int r=0;r<16;++r){const int orow=crow(r,hi);
      #pragma unroll
      for(int d0=0;d0<2;++d0)stg[orow*64+d0*32+r32]=__float2bfloat16(o[d0][r]*rli[r]);}
    asm volatile("s_waitcnt lgkmcnt(0)":::"memory");
    #pragma unroll
    for(int i=0;i<4;++i){const int row=i*8+(lane>>3),ch=lane&7; const u32x4 v=*(const u32x4*)(stg+row*64+ch*8); ATTN_STORE16(Ow+(long)row*PO+ch*8,v);} }
  asm volatile("s_waitcnt lgkmcnt(0)\n\ts_barrier":::"memory");
  #undef DMA_K
  #undef DMA_V
  #undef CMASK
  #undef START
  #undef RESC
  #undef ROT
}
constexpr int ATTN_LDS_BYTES=LDS_BYTES;
struct AttnTensors { const bf16* Q; const bf16* K; const bf16* V; bf16* O; };
struct AttnUnit { int th; int qb; };
struct StaticOrder {
  int vcu, G;
  __device__ __forceinline__ explicit StaticOrder(int grid,int v):vcu(v),G(grid){}
  __device__ __forceinline__ bool next(int i,AttnUnit&u)const{ const int th=vcu+(i>>3)*G; if(th>=256)return false; const int half=th&1,j=i&7,p=half*4+(j>>1); u.th=th; u.qb=(j&1)?15-p:p; return true; }
  __device__ __forceinline__ void a_ready(const AttnUnit&)const{}
  __device__ __forceinline__ void done(const AttnUnit&)const{}
};
template<class Sched,int THRL=8> __device__ __forceinline__ void attn_phase(char*lds,const AttnTensors&T,const Sched&S){
  AttnUnit u;
  for(int i=0;S.next(i,u);++i){ S.a_ready(u); const int triple=u.th>>1,b=triple>>4,hm=(triple>>1)&7,vh=triple&1;
    attn_unit<THRL>(b,u.qb,T.Q+hm*64,T.K+hm*64,T.V+(hm>>1)*128+vh*64,T.O+hm*128+vh*64,lds); S.done(u); }
}
#undef SBAR
#undef WAIT_BAR
}
#define GAS __attribute__((address_space(1)))
#define LAS __attribute__((address_space(3)))
typedef unsigned short bf16;
typedef unsigned v4u __attribute__((ext_vector_type(4)));
typedef float f32x4 __attribute__((ext_vector_type(4)));
typedef short bf16x8 __attribute__((ext_vector_type(8)));
typedef GAS unsigned gu32;
typedef GAS unsigned long long gu64;
#define RLX_AGENT __ATOMIC_RELAXED, __HIP_MEMORY_SCOPE_AGENT
#define LDS_WAIT() asm volatile("s_waitcnt lgkmcnt(0)" ::: "memory")
#define VM_WAIT() asm volatile("s_waitcnt vmcnt(0)" ::: "memory")
__device__ __forceinline__ unsigned long long rt() { return __builtin_amdgcn_s_memrealtime(); }
__device__ __forceinline__ unsigned f2bf(float f) { unsigned u = __builtin_bit_cast(unsigned, f); return (u + 0x7fffu + ((u >> 16) & 1u)) >> 16; }
__device__ __forceinline__ unsigned pk2(float lo, float hi) { return f2bf(lo) | (f2bf(hi) << 16); }

#define XB_TMO      128
#define XB_XCNT(j)  (256  + 64 * (j))
#define XB_XSUB(j)  (1280 + 64 * (j))
#define XB_XGEN(j)  (2304 + 64 * (j))
#define XB_TOP      3328
#define XB_TOPGEN   3392
#define XCD_BAR_WORDS 3456
#define XB_SPIN_CAP (1u << 22)

__device__ __forceinline__ unsigned xb_ld(unsigned* p)              { return __hip_atomic_load(p, __ATOMIC_RELAXED, __HIP_MEMORY_SCOPE_AGENT); }
__device__ __forceinline__ unsigned xb_add(unsigned* p, unsigned v) { return __hip_atomic_fetch_add(p, v, __ATOMIC_RELAXED, __HIP_MEMORY_SCOPE_AGENT); }
__device__ __forceinline__ unsigned xb_xcc_id() { return (unsigned)__builtin_amdgcn_s_getreg((3 << 11) | 20) & 0xFu; }
#define XB_SPIN(cond, bar) do { unsigned _sp = 0; while (cond) { __builtin_amdgcn_s_sleep(1); \
    if ((++_sp & 255u) == 0u) { if (xb_ld(&(bar)[XB_TMO])) break; if (_sp > XB_SPIN_CAP) { atomicAdd(&(bar)[XB_TMO], 1u); break; } } } } while (0)

struct XcdBarrier {
    unsigned* bar; unsigned x;
    volatile LAS unsigned* st;
};

__device__ __forceinline__ XcdBarrier xcd_barrier_post(unsigned* bar, volatile LAS unsigned* st) {
    XcdBarrier b; b.bar = bar; b.x = xb_xcc_id(); b.st = st;
    if (threadIdx.x == 0) (void)xb_add(&bar[XB_XCNT(b.x)], 1u);
    return b;
}
__device__ __forceinline__ void xcd_barrier_complete(unsigned* bar, unsigned x, unsigned& nloc, unsigned& nx) {
    const unsigned G = gridDim.x * gridDim.y * gridDim.z;
    unsigned sum, cnt, mine, sp = 0u;
    for (;;) {
        sum = 0u; cnt = 0u; mine = 0u;
#pragma unroll
        for (unsigned j = 0; j < 16; ++j) { const unsigned c = xb_ld(&bar[XB_XCNT(j)]); sum += c; cnt += (c > 0u) ? 1u : 0u; mine = (j == x) ? c : mine; }
        if (sum == G) break;
        __builtin_amdgcn_s_sleep(1);
        if ((++sp & 255u) == 0u) { if (xb_ld(&bar[XB_TMO])) break; if (sp > XB_SPIN_CAP) { atomicAdd(&bar[XB_TMO], 1u); break; } }
    }
    nloc = mine > 0u ? mine : 1u; nx = cnt > 0u ? cnt : 1u;
}

__device__ __forceinline__ void xcd_barrier(const XcdBarrier& b) {
    asm volatile("s_waitcnt vmcnt(0)" ::: "memory");
    __syncthreads();
    if (threadIdx.x == 0) {
        unsigned* bar = b.bar;
        __builtin_amdgcn_s_waitcnt(0);
        unsigned nloc = b.st[0], nx = b.st[1];
        if (nloc == 0u) { xcd_barrier_complete(bar, b.x, nloc, nx); b.st[0] = nloc; b.st[1] = nx; }
        const unsigned old = xb_add(&bar[XB_XSUB(b.x)], 1u);
        const unsigned gen = old / nloc;
        if (old + 1u == (gen + 1u) * nloc) {
            __builtin_amdgcn_fence(__ATOMIC_RELEASE, "agent");
            asm volatile("s_waitcnt vmcnt(0)" ::: "memory");
            const unsigned og = xb_add(&bar[XB_TOP], 1u);
            const unsigned tg = og / nx;
            if (og + 1u == (tg + 1u) * nx) xb_add(&bar[XB_TOPGEN], 1u);
            else XB_SPIN(xb_ld(&bar[XB_TOPGEN]) == tg, bar);
            __builtin_amdgcn_fence(__ATOMIC_ACQUIRE, "agent");
            xb_add(&bar[XB_XGEN(b.x)], 1u);
            asm volatile("s_waitcnt vmcnt(0)" ::: "memory");
        } else {
            XB_SPIN(xb_ld(&bar[XB_XGEN(b.x)]) == gen, bar);
            __builtin_amdgcn_fence(__ATOMIC_ACQUIRE, "agent");
            asm volatile("s_waitcnt vmcnt(0)" ::: "memory");
        }
    }
    __syncthreads();
}

constexpr int NWAVES = 8;
constexpr int NTOK = 32768, SEQL = 4096, DMODEL = 1024, INW = 2560, FFND = 2816, NEXP = 8, EDIM = 3584;
constexpr int MAXTILES = 264;
constexpr int CHUNK_TILES = 64, NCHUNK = 5;
constexpr size_t MiB = 1u << 20;
constexpr size_t WS_CTL = 0, CTL_ZERO_BYTES = 1 * MiB;
constexpr size_t WS_WIN = 1 * MiB, WS_WOUT = 6 * MiB, WS_WF1 = 8 * MiB, WS_WF2 = 19 * MiB, WS_WPL = 25 * MiB, WS_WM1 = 26 * MiB, WS_WM2 = 138 * MiB;
constexpr size_t WS_TAB = 194 * MiB;
constexpr size_t WS_ROPE = WS_TAB, WS_SSQ1 = WS_TAB + 1 * MiB, WS_SSQ2 = WS_TAB + 3 * MiB, WS_TOPK = WS_TAB + 5 * MiB, WS_CNT = WS_TAB + 5 * MiB + 512 * 1024,
                 WS_STOK = WS_TAB + 6 * MiB, WS_SSLOT = WS_TAB + 6 * MiB + 512 * 1024, WS_SGATE = WS_TAB + 7 * MiB, WS_TINFO = WS_TAB + 7 * MiB + 512 * 1024;
constexpr size_t WS_SLOTA = 202 * MiB;
constexpr size_t WS_PROJ = 266 * MiB;
constexpr size_t WS_OS = 426 * MiB;
constexpr size_t WS_H1B = 266 * MiB;
constexpr size_t WS_HID = 330 * MiB;
constexpr size_t WS_Y = 266 * MiB;
constexpr size_t WS_HIDS = 394 * MiB;
constexpr size_t WS_END = 512 * MiB;
static_assert(WS_HID + (size_t)NTOK * FFND * 2 <= WS_END && WS_HIDS + (size_t)CHUNK_TILES * 256 * EDIM * 2 <= WS_END && WS_OS + (size_t)NTOK * 1024 * 2 <= WS_END, "d_ws map");
static_assert(WS_WM1 + (size_t)NEXP * 7168 * 1024 * 2 <= WS_WM2 && WS_WM2 + (size_t)NEXP * 1024 * EDIM * 2 <= WS_TAB, "d_ws weights map");
constexpr int CW_TMO = 0, CW_CODE = 1, CW_BAR = 4096;
constexpr int RING_OFF = 0, RING_BYTES = 131072;
constexpr int LDSCTL_OFF = RING_BYTES, MISC_OFF = LDSCTL_OFF + 320;
constexpr int LDS_BYTES = 147456;
static_assert(MISC_OFF + 128 <= LDS_BYTES, "LDS map");

__device__ __forceinline__ float wave_sum(float v) {
#pragma unroll
    for (int o = 1; o < 64; o <<= 1) v += __shfl_xor(v, o);
    return v;
}
__device__ __forceinline__ float bf2f(bf16 v) { return __builtin_bit_cast(float, (unsigned)v << 16); }
__device__ __forceinline__ float sigmoidf_(float x) { return 1.0f / (1.0f + __expf(-x)); }
__device__ __forceinline__ float gelu_tanh(float x) { const float z = 0.7978845608028654f * (x + 0.044715f * x * x * x); const float t = 1.0f - 2.0f / (1.0f + __expf(2.0f * z)); return 0.5f * x * (1.0f + t); }

__device__ __forceinline__ void tr_item(const float* W, int N, int k0, int n0, const float* gain, bf16* WT, size_t drow0, int ldk, LAS float* scr, int lane) {
#pragma unroll 8
    for (int i = 0; i < 32; ++i) { const int kk = 2 * i + (lane >> 5); const float g = gain ? gain[k0 + kk] : 1.0f; scr[kk * 33 + (lane & 31)] = W[(size_t)(k0 + kk) * N + n0 + (lane & 31)] * g; }
    LDS_WAIT(); asm volatile("" ::: "memory");
    const int c = lane & 7;
#pragma unroll
    for (int j = 0; j < 4; ++j) { const int n = (lane >> 3) + 8 * j; const LAS float* s = scr + (8 * c) * 33 + n;
        v4u o; o.x = pk2(s[0 * 33], s[1 * 33]); o.y = pk2(s[2 * 33], s[3 * 33]); o.z = pk2(s[4 * 33], s[5 * 33]); o.w = pk2(s[6 * 33], s[7 * 33]);
        *(GAS v4u*)(WT + (drow0 + n) * (size_t)ldk + k0 + 8 * c) = o; }
    LDS_WAIT(); asm volatile("" ::: "memory");
}

struct Args { const float* in[29]; float* out; unsigned char* ws; int ph_lo, ph_hi; };
constexpr int PH_FINAL = 21, PH_END = 22;

__global__ void __launch_bounds__(NWAVES * 64, 2) mk_fwd(Args args) {
    extern __shared__ __attribute__((aligned(16))) unsigned char lds_raw[];
    LAS unsigned char* lds = (LAS unsigned char*)lds_raw;
    volatile LAS unsigned* MISC = (volatile LAS unsigned*)(lds + MISC_OFF);
    const int G = gridDim.x, bid = blockIdx.x;
    const int vcu = (G % 8 == 0) ? (bid % 8) * (G / 8) + bid / 8 : bid;
    typedef const __attribute__((address_space(4))) char* kargp_t;
#define KARG(kp) kargp_t kp = (kargp_t)__builtin_amdgcn_kernarg_segment_ptr(); asm volatile("" : "+s"(kp))
#define KIN(kp, k) (*(const float* const __attribute__((address_space(4)))*)((kp) + 8 * (k)))
#define KOUT(kp) (*(float* const __attribute__((address_space(4)))*)((kp) + 232))
#define KWS(kp) (*(unsigned char* const __attribute__((address_space(4)))*)((kp) + 240))
    gu32* ctl;
    { KARG(kp); ctl = (gu32*)(KWS(kp) + WS_CTL); }
    for (int u = threadIdx.x; u < (LDS_BYTES - LDSCTL_OFF) / 4; u += NWAVES * 64) ((LAS unsigned*)(lds + LDSCTL_OFF))[u] = 0u;
    __syncthreads();
    const int lo = args.ph_lo, hi = args.ph_hi;
    const bool multi = (hi - lo) > 1;
    XcdBarrier bar; bar.bar = (unsigned*)(ctl + CW_BAR); bar.x = 0; bar.st = nullptr;
    if (multi) bar = xcd_barrier_post((unsigned*)(ctl + CW_BAR), MISC + 8);
#ifndef PHMASK
#define PHMASK 0xffffffffu
#endif
#define IN(k) (((PHMASK >> ((k) > 11 ? ((k)&1) ? 11 : 12 : (k))) & 1u) && lo <= (k) && (k) < hi)
#define BOTH(k) (IN(k) && IN((k) + 1))
#define GRID_BAR() xcd_barrier(bar)
#define PHASE_IDS() int tid_ = threadIdx.x; asm volatile("" : "+v"(tid_)); const int tid = tid_, lane = tid & 63, wave = __builtin_amdgcn_readfirstlane(tid >> 6), gw = vcu * NWAVES + wave, NGW = G * NWAVES; (void)lane; (void)gw; (void)NGW

    if (IN(0)) {
        PHASE_IDS(); KARG(kp); unsigned char* ws = KWS(kp);
        const float* x = KIN(kp, 0); const float* ln_mix_even = KIN(kp, 1); const float* w_in = KIN(kp, 2); const float* w_out = KIN(kp, 15); const float* ln_ffn_even = KIN(kp, 16);
        const float* ffn_wg = KIN(kp, 17); const float* ffn_wu = KIN(kp, 18); const float* ffn_wd = KIN(kp, 19); const float* ln_mix_odd = KIN(kp, 20); const float* pool_w = KIN(kp, 21);
        const float* ln_ffn_odd = KIN(kp, 23); const float* moe_wg = KIN(kp, 25); const float* moe_wu = KIN(kp, 26); const float* moe_wd = KIN(kp, 27);
        bf16* WIN = (bf16*)(ws + WS_WIN); bf16* WOUT = (bf16*)(ws + WS_WOUT); bf16* WF1 = (bf16*)(ws + WS_WF1); bf16* WF2 = (bf16*)(ws + WS_WF2);
        bf16* WPL = (bf16*)(ws + WS_WPL); bf16* WM1 = (bf16*)(ws + WS_WM1); bf16* WM2 = (bf16*)(ws + WS_WM2); float* ROPE = (float*)(ws + WS_ROPE); bf16* SLOTA = (bf16*)(ws + WS_SLOTA);
        LAS float* scr = (LAS float*)(lds + RING_OFF + wave * 16384);
        constexpr int I_IN = 16 * 80, I_OUT = 16 * 32, I_F1 = 16 * 88, I_F2 = 44 * 32, I_PL = 4 * 32, I_M1 = 8 * 16 * 112, I_M2 = 8 * 56 * 32;
        constexpr int NITEMS = I_IN + I_OUT + 2 * I_F1 + I_F2 + I_PL + 2 * I_M1 + I_M2;
        for (int it = gw; it < NITEMS; it += NGW) {
            int r = it;
            if (r < I_IN) { const int kb = r / 80, nb = r % 80; tr_item(w_in, INW, 64 * kb, 32 * nb, ln_mix_even, WIN, 32 * nb, 1024, scr, lane); continue; } r -= I_IN;
            if (r < I_OUT) { const int kb = r / 32, nb = r % 32; tr_item(w_out, 1024, 64 * kb, 32 * nb, nullptr, WOUT, 32 * nb, 1024, scr, lane); continue; } r -= I_OUT;
            if (r < 2 * I_F1) { const int up = r >= I_F1 ? 1 : 0, rr = r - up * I_F1, kb = rr / 88, nb = rr % 88, n0 = 32 * nb;
                tr_item(up ? ffn_wu : ffn_wg, FFND, 64 * kb, n0, ln_ffn_even, WF1, (size_t)(256 * (n0 / 128) + (n0 % 128) + up * 128), 1024, scr, lane); continue; } r -= 2 * I_F1;
            if (r < I_F2) { const int kb = r / 32, nb = r % 32; tr_item(ffn_wd, 1024, 64 * kb, 32 * nb, nullptr, WF2, 32 * nb, FFND, scr, lane); continue; } r -= I_F2;
            if (r < I_PL) { const int g = r / 32, rr = r % 32, kb = rr / 8, nb = rr % 8; tr_item(pool_w + (size_t)g * 65536, 256, 64 * kb, 32 * nb, ln_mix_odd + 256 * g, WPL, (size_t)(256 * g + 32 * nb), 256, scr, lane); continue; } r -= I_PL;
            if (r < 2 * I_M1) { const int up = r >= I_M1 ? 1 : 0, rr = r - up * I_M1, e = rr / 1792, r2 = rr % 1792, kb = r2 / 112, nb = r2 % 112, n0 = 32 * nb;
                tr_item((up ? moe_wu : moe_wg) + (size_t)e * 1024 * EDIM, EDIM, 64 * kb, n0, ln_ffn_odd, WM1, (size_t)e * 7168 + (size_t)(256 * (n0 / 128) + (n0 % 128) + up * 128), 1024, scr, lane); continue; } r -= 2 * I_M1;
            { const int e = r / 1792, r2 = r % 1792, kb = r2 / 32, nb = r2 % 32; tr_item(moe_wd + (size_t)e * EDIM * 1024, 1024, 64 * kb, 32 * nb, nullptr, WM2, (size_t)e * 1024 + 32 * nb, EDIM, scr, lane); }
        }
        for (int e = bid * (NWAVES * 64) + tid; e < SEQL * 8; e += G * NWAVES * 64) {
            const int pos = e >> 3, i = e & 7;
            const float inv = (i == 0) ? 1.000000000e+00f : (i == 1) ? 1.939227432e-01f : (i == 2) ? 3.760603070e-02f : (i == 3) ? 7.292664610e-03f : (i == 4) ? 1.414213562e-03f : (i == 5) ? 2.742481884e-04f : (i == 6) ? 5.318295734e-05f : 1.031338525e-05f;
            const float angf = (float)pos * inv; const double a = (double)angf;
            const double q = __builtin_rint(a * 0.63661977236758134308); const double rr = (a - q * 1.57079632679489655800) - q * 6.123233995736766036e-17; const int qi = (int)q & 3;
            const double r2 = rr * rr;
            const double sn = rr * (1.0 + r2 * (-1.0 / 6 + r2 * (1.0 / 120 + r2 * (-1.0 / 5040 + r2 * (1.0 / 362880 + r2 * (-1.0 / 39916800 + r2 * (1.0 / 6227020800.0)))))));
            const double cn = 1.0 + r2 * (-0.5 + r2 * (1.0 / 24 + r2 * (-1.0 / 720 + r2 * (1.0 / 40320 + r2 * (-1.0 / 3628800 + r2 * (1.0 / 479001600 + r2 * (-1.0 / 87178291200.0)))))));
            const double c = (qi == 0) ? cn : (qi == 1) ? -sn : (qi == 2) ? -cn : sn, s = (qi == 0) ? sn : (qi == 1) ? cn : (qi == 2) ? -sn : -cn;
            ROPE[2 * e] = (float)c; ROPE[2 * e + 1] = (float)s;
        }
        for (int m = gw; m < NTOK; m += NGW) {
            const GAS f32x4* xr = (const GAS f32x4*)(x + (size_t)m * DMODEL) + lane;
            f32x4 v[4]; float s = 0.f;
#pragma unroll
            for (int j = 0; j < 4; ++j) { v[j] = xr[64 * j]; s += (v[j].x * v[j].x + v[j].y * v[j].y) + (v[j].z * v[j].z + v[j].w * v[j].w); }
            const float rstd = 1.0f / sqrtf(wave_sum(s) * (1.f / DMODEL) + 1e-6f);
            GAS unsigned long long* o8 = (GAS unsigned long long*)(SLOTA + (size_t)m * DMODEL) + lane;
#pragma unroll
            for (int j = 0; j < 4; ++j) o8[64 * j] = (unsigned long long)pk2(v[j].x * rstd, v[j].y * rstd) | ((unsigned long long)pk2(v[j].z * rstd, v[j].w * rstd) << 32);
        }
        if (BOTH(0)) GRID_BAR();
    }

    if (IN(1)) {
        KARG(kp); unsigned char* ws = KWS(kp);
        bf16* WIN = (bf16*)(ws + WS_WIN); float* ROPE = (float*)(ws + WS_ROPE); bf16* SLOTA = (bf16*)(ws + WS_SLOTA); bf16* PROJ = (bf16*)(ws + WS_PROJ);
        pg8::GSched S{}; S.so.init(NTOK, INW, G, bid); S.A = (const char*)SLOTA; S.a_pm = 256 * 1024 * 2; S.a_pn = 0; S.B = (const char*)WIN; S.b_pn = 256 * 1024 * 2; S.b_e = 0; S.rowidx = nullptr; S.pm0 = 0;
        pg8::EpiInProj E{PROJ, ROPE};
        pg8::gemm_phase2<pg8::EpiInProj, false, true>(lds + RING_OFF, S, 1024, 1024, 1024, E);
        if (BOTH(1)) GRID_BAR();
    }

    if (IN(2)) {
        PHASE_IDS(); KARG(kp); unsigned char* ws = KWS(kp);
        const float* conv_w = KIN(kp, 8); const float* conv_b = KIN(kp, 9); const float* rg_wa = KIN(kp, 10); const float* rg_ba = KIN(kp, 11); const float* rg_wx = KIN(kp, 12); const float* rg_bx = KIN(kp, 13); const float* rg_lam = KIN(kp, 14);
        bf16* SLOTA = (bf16*)(ws + WS_SLOTA); bf16* PROJ = (bf16*)(ws + WS_PROJ); bf16* OS = (bf16*)(ws + WS_OS);
#ifndef NO_RGLRU
        for (int chain = vcu; chain < 64; chain += G) {
            const int b = chain >> 3, hd = chain & 7, c = tid & 63, s = wave;
            LAS float* XC = (LAS float*)(lds + RING_OFF);
            LAS float* SP = XC + 128 * 64;
            LAS float* SH = SP + 512;
            LAS float* HIN = SH + 512;
            float wa[64], wx[64];
#pragma unroll
            for (int k = 0; k < 64; ++k) { wa[k] = rg_wa[(size_t)(hd * 64 + k) * 64 + c]; wx[k] = rg_wx[(size_t)(hd * 64 + k) * 64 + c]; }
            const float ba = rg_ba[hd * 64 + c], bx = rg_bx[hd * 64 + c], spl = log1pf(__expf(-rg_lam[hd * 64 + c]));
            const float cw0 = conv_w[0 * 512 + hd * 64 + c], cw1 = conv_w[1 * 512 + hd * 64 + c], cw2 = conv_w[2 * 512 + hd * 64 + c], cw3 = conv_w[3 * 512 + hd * 64 + c], cb = conv_b[hd * 64 + c];
            if (tid < 64) HIN[c] = 0.f;
            __syncthreads();
            const bf16* xbp = PROJ + (size_t)(b * SEQL) * INW + 1536 + hd * 64 + c;
            const bf16* gbp = PROJ + (size_t)(b * SEQL) * INW + 2048 + hd * 64 + c;
            bf16* rp = SLOTA + (size_t)(b * SEQL) * 1024 + 512 + hd * 64 + c;
            for (int seg = 0; seg < SEQL / 128; ++seg) {
                const int t0 = seg * 128 + s * 16;
                float xc[16];
                { float xw[19];
#pragma unroll
                  for (int j = 0; j < 19; ++j) { const int t = t0 - 3 + j; xw[j] = (t >= 0) ? bf2f(xbp[(size_t)(t < 0 ? 0 : t) * INW]) : 0.f; }
#pragma unroll
                  for (int i = 0; i < 16; ++i) xc[i] = cb + ((cw0 * xw[i] + cw1 * xw[i + 1]) + (cw2 * xw[i + 2] + cw3 * xw[i + 3])); }
#pragma unroll
                for (int i = 0; i < 16; ++i) XC[(s * 16 + i) * 64 + c] = xc[i];
                __syncthreads();
                float hl[16], cp[16]; float h = 0.f, P = 1.f;
#pragma unroll
                for (int i = 0; i < 16; ++i) {
                    const LAS f32x4* xr = (const LAS f32x4*)(XC + (s * 16 + i) * 64);
                    float da = ba, dx = bx;
#pragma unroll
                    for (int k4 = 0; k4 < 16; ++k4) { const f32x4 v = xr[k4];
                        da += (v.x * wa[4 * k4] + v.y * wa[4 * k4 + 1]) + (v.z * wa[4 * k4 + 2] + v.w * wa[4 * k4 + 3]);
                        dx += (v.x * wx[4 * k4] + v.y * wx[4 * k4 + 1]) + (v.z * wx[4 * k4 + 2] + v.w * wx[4 * k4 + 3]); }
                    const float r = sigmoidf_(da), ig = sigmoidf_(dx), la = -8.0f * r * spl;
                    const float a = __expf(la), mult = sqrtf(-expm1f(2.0f * la)), uu = mult * (ig * xc[i]);
                    h = a * h + uu; P *= a; hl[i] = h; cp[i] = P;
                }
                SP[s * 64 + c] = P; SH[s * 64 + c] = h;
                __syncthreads();
                float base = HIN[c];
                for (int s2 = 0; s2 < s; ++s2) base = SP[s2 * 64 + c] * base + SH[s2 * 64 + c];
#pragma unroll
                for (int i = 0; i < 16; ++i) { const float hh = hl[i] + cp[i] * base; const float g = bf2f(gbp[(size_t)(t0 + i) * INW]); rp[(size_t)(t0 + i) * 1024] = (bf16)f2bf(hh * gelu_tanh(g)); }
                __syncthreads();
                if (s == 7) HIN[c] = hl[15] + cp[15] * base;
            }
            __syncthreads();
        }
#endif
#ifndef NO_ATTN
        {
            const attn_body::AttnTensors AT{(const attn_body::bf16*)PROJ, (const attn_body::bf16*)PROJ + 512, (const attn_body::bf16*)PROJ + 1024, (attn_body::bf16*)OS};
            const attn_body::StaticOrder SA(G, vcu);
            attn_body::attn_phase<attn_body::StaticOrder>((char*)lds_raw + RING_OFF, AT, SA);
        }
#endif
        if (BOTH(2)) GRID_BAR();
    }

    if (IN(3)) {
        PHASE_IDS(); KARG(kp); unsigned char* ws = KWS(kp);
        const float* lam_q1 = KIN(kp, 3); const float* lam_k1 = KIN(kp, 4); const float* lam_q2 = KIN(kp, 5); const float* lam_k2 = KIN(kp, 6); const float* subln_g = KIN(kp, 7);
        bf16* SLOTA = (bf16*)(ws + WS_SLOTA); bf16* OS = (bf16*)(ws + WS_OS);
        const float d1 = wave_sum(lam_q1[lane] * lam_k1[lane]), d2 = wave_sum(lam_q2[lane] * lam_k2[lane]);
        const float lam = expf(d1) - expf(d2) + 0.2f;
        const int h = lane >> 4, dc = lane & 15;
        const f32x4 g0 = *(const f32x4*)(subln_g + 8 * dc), g1 = *(const f32x4*)(subln_g + 8 * dc + 4);
        for (int m = gw; m < NTOK; m += NGW) {
            const v4u a = *(const GAS v4u*)(OS + (size_t)m * 1024 + 256 * h + 8 * dc), bq = *(const GAS v4u*)(OS + (size_t)m * 1024 + 256 * h + 128 + 8 * dc);
            float w[8]; float ss = 0.f;
#pragma unroll
            for (int j = 0; j < 4; ++j) { const unsigned ua = a[j], ub = bq[j];
                w[2 * j] = __builtin_bit_cast(float, ua << 16) - lam * __builtin_bit_cast(float, ub << 16);
                w[2 * j + 1] = __builtin_bit_cast(float, ua & 0xffff0000u) - lam * __builtin_bit_cast(float, ub & 0xffff0000u); }
#pragma unroll
            for (int j = 0; j < 8; ++j) ss += w[j] * w[j];
            ss += __shfl_xor(ss, 1); ss += __shfl_xor(ss, 2); ss += __shfl_xor(ss, 4); ss += __shfl_xor(ss, 8);
            const float rs = 0.8f / sqrtf(ss * (1.0f / 128.0f) + 1e-5f);
            v4u o; o.x = pk2(w[0] * rs * g0.x, w[1] * rs * g0.y); o.y = pk2(w[2] * rs * g0.z, w[3] * rs * g0.w); o.z = pk2(w[4] * rs * g1.x, w[5] * rs * g1.y); o.w = pk2(w[6] * rs * g1.z, w[7] * rs * g1.w);
            *(GAS v4u*)(SLOTA + (size_t)m * 1024 + 128 * h + 8 * dc) = o;
        }
        if (BOTH(3)) GRID_BAR();
    }

    if (IN(4)) {
        KARG(kp); unsigned char* ws = KWS(kp); const float* x = KIN(kp, 0); float* H = KOUT(kp);
        bf16* WOUT = (bf16*)(ws + WS_WOUT); bf16* SLOTA = (bf16*)(ws + WS_SLOTA); bf16* H1B = (bf16*)(ws + WS_H1B); float* SSQ1 = (float*)(ws + WS_SSQ1);
        pg8::GSched S{}; S.so.init(NTOK, 1024, G, bid); S.A = (const char*)SLOTA; S.a_pm = 256 * 1024 * 2; S.B = (const char*)WOUT; S.b_pn = 256 * 1024 * 2;
        pg8::EpiResid<true> E{x, H, H1B, SSQ1};
        pg8::gemm_phase2<pg8::EpiResid<true>, false, true>(lds + RING_OFF, S, 1024, 1024, 1024, E);
        if (BOTH(4)) GRID_BAR();
    }

    if (IN(5)) {
        KARG(kp); unsigned char* ws = KWS(kp);
        bf16* WF1 = (bf16*)(ws + WS_WF1); bf16* H1B = (bf16*)(ws + WS_H1B); bf16* HID = (bf16*)(ws + WS_HID); float* SSQ1 = (float*)(ws + WS_SSQ1);
        pg8::GSched S{}; S.so.init(NTOK, 2 * FFND, G, bid); S.A = (const char*)H1B; S.a_pm = 256 * 1024 * 2; S.B = (const char*)WF1; S.b_pn = 256 * 1024 * 2;
        pg8::EpiSwiGLU<true> E{HID, FFND, SSQ1};
        pg8::gemm_phase2<pg8::EpiSwiGLU<true>, false, true>(lds + RING_OFF, S, 1024, 1024, 1024, E);
        if (BOTH(5)) GRID_BAR();
    }

    if (IN(6)) {
        KARG(kp); unsigned char* ws = KWS(kp); float* H = KOUT(kp);
        bf16* WF2 = (bf16*)(ws + WS_WF2); bf16* HID = (bf16*)(ws + WS_HID); float* SSQ2 = (float*)(ws + WS_SSQ2);
        pg8::GSched S{}; S.so.init(NTOK, 1024, G, bid); S.A = (const char*)HID; S.a_pm = 256 * FFND * 2; S.B = (const char*)WF2; S.b_pn = 256 * FFND * 2;
        pg8::EpiResid<false> E{H, H, nullptr, SSQ2};
        pg8::gemm_phase2<pg8::EpiResid<false>, false, true>(lds + RING_OFF, S, FFND, FFND, FFND, E);
        if (BOTH(6)) GRID_BAR();
    }

    if (IN(7)) {
        PHASE_IDS(); KARG(kp); unsigned char* ws = KWS(kp); float* H = KOUT(kp);
        bf16* SLOTA = (bf16*)(ws + WS_SLOTA); float* SSQ2 = (float*)(ws + WS_SSQ2);
        LAS float* RS = (LAS float*)(lds + RING_OFF);
        for (int blk = bid; blk < NTOK / 128; blk += G) {
            const int t0 = blk * 128, pos0 = t0 & (SEQL - 1);
            if (tid < 144) { const int row = t0 - 16 + tid; float rs = 0.f;
                if (row >= 0) { const f32x4* sp = (const f32x4*)(SSQ2 + (size_t)row * 16); const f32x4 t = (sp[0] + sp[1]) + (sp[2] + sp[3]); rs = 1.0f / sqrtf(((t[0] + t[1]) + (t[2] + t[3])) * (1.0f / 1024.0f) + 1e-6f); }
                RS[tid] = rs; }
            __syncthreads();
            const int w = 2 << (tid >> 7);
            const float* hp = H + 2 * tid;
            float s0 = 0.f, s1 = 0.f;
            for (int j = 1; j <= 16; ++j) if (j <= w && pos0 - j >= 0) { const float2 v = *(const float2*)(hp + (size_t)(t0 - j) * 1024); const float rs = RS[16 - j]; s0 += v.x * rs; s1 += v.y * rs; }
#pragma unroll 4
            for (int i = 0; i < 128; ++i) {
                const int pos = pos0 + i; const float2 v = *(const float2*)(hp + (size_t)(t0 + i) * 1024); const float rs = RS[16 + i];
                const float a0 = v.x * rs, a1 = v.y * rs;
                s0 += a0; s1 += a1;
                if (pos - w >= 0) { const float2 o = *(const float2*)(hp + (size_t)(t0 + i - w) * 1024); const float ro = RS[16 + i - w]; s0 -= o.x * ro; s1 -= o.y * ro; }
                const float ic = 1.0f / (float)((pos + 1 < w) ? pos + 1 : w);
                *(GAS unsigned*)(SLOTA + (size_t)(t0 + i) * 1024 + 2 * tid) = pk2(s0 * ic - a0, s1 * ic - a1);
            }
            __syncthreads();
        }
        if (BOTH(7)) GRID_BAR();
    }

    if (IN(8)) {
        KARG(kp); unsigned char* ws = KWS(kp); float* H = KOUT(kp); const float* pool_scale = KIN(kp, 22);
        bf16* SLOTA = (bf16*)(ws + WS_SLOTA); bf16* WPL = (bf16*)(ws + WS_WPL);
        pg8::GSched S{}; S.so.init(NTOK, 1024, G, bid); S.A = (const char*)SLOTA; S.a_pm = 256 * 1024 * 2; S.a_pn = 512; S.B = (const char*)WPL; S.b_pn = 256 * 256 * 2;
        pg8::EpiPool E{H, pool_scale};
        pg8::gemm_phase2<pg8::EpiPool, false, true>(lds + RING_OFF, S, 256, 1024, 256, E);
        if (BOTH(8)) GRID_BAR();
    }

    if (IN(9)) {
        PHASE_IDS(); KARG(kp); unsigned char* ws = KWS(kp); float* H = KOUT(kp); const float* ln_ffn_odd = KIN(kp, 23); const float* router_w = KIN(kp, 24);
        bf16* SLOTA = (bf16*)(ws + WS_SLOTA); v4u* TOPK = (v4u*)(ws + WS_TOPK); int* CNT = (int*)(ws + WS_CNT);
        LAS float* GW = (LAS float*)(lds + RING_OFF);
        LAS int* LC = (LAS int*)(lds + RING_OFF + 32768);
        for (int i = tid; i < 8192; i += NWAVES * 64) GW[i] = ln_ffn_odd[i >> 3] * router_w[i];
        __syncthreads();
        for (int blk = bid; blk < NTOK / 128; blk += G) {
            if (tid < 8) LC[tid] = 0;
            __syncthreads();
            for (int rr = wave; rr < 128; rr += NWAVES) {
                const int m = blk * 128 + rr;
                const GAS f32x4* xr = (const GAS f32x4*)(H + (size_t)m * DMODEL) + lane;
                f32x4 v[4]; float ss = 0.f; float lg[8];
#pragma unroll
                for (int e = 0; e < 8; ++e) lg[e] = 0.f;
#pragma unroll
                for (int j = 0; j < 4; ++j) { v[j] = xr[64 * j]; ss += (v[j].x * v[j].x + v[j].y * v[j].y) + (v[j].z * v[j].z + v[j].w * v[j].w);
                    const LAS f32x4* gp = (const LAS f32x4*)(GW + (size_t)(4 * (lane + 64 * j)) * 8);
#pragma unroll
                    for (int q = 0; q < 4; ++q) { const f32x4 ga = gp[2 * q], gb = gp[2 * q + 1]; const float xv = v[j][q];
                        lg[0] += xv * ga.x; lg[1] += xv * ga.y; lg[2] += xv * ga.z; lg[3] += xv * ga.w; lg[4] += xv * gb.x; lg[5] += xv * gb.y; lg[6] += xv * gb.z; lg[7] += xv * gb.w; } }
                ss = wave_sum(ss);
#pragma unroll
                for (int e = 0; e < 8; ++e) lg[e] = wave_sum(lg[e]);
                const float rstd = 1.0f / sqrtf(ss * (1.f / DMODEL) + 1e-6f);
                int e1 = 0; float l1 = lg[0];
#pragma unroll
                for (int e = 1; e < 8; ++e) if (lg[e] > l1) { l1 = lg[e]; e1 = e; }
                int e2 = -1; float l2 = -3.0e38f;
#pragma unroll
                for (int e = 0; e < 8; ++e) if (e != e1 && lg[e] > l2) { l2 = lg[e]; e2 = e; }
                const float g1 = 1.0f / (1.0f + expf((l2 - l1) * rstd)), g2 = 1.0f - g1;
                GAS unsigned long long* o8 = (GAS unsigned long long*)(SLOTA + (size_t)m * DMODEL) + lane;
#pragma unroll
                for (int j = 0; j < 4; ++j) o8[64 * j] = (unsigned long long)pk2(v[j].x * rstd, v[j].y * rstd) | ((unsigned long long)pk2(v[j].z * rstd, v[j].w * rstd) << 32);
                if (lane == 0) { v4u tk; tk.x = (unsigned)e1; tk.y = (unsigned)e2; tk.z = __builtin_bit_cast(unsigned, g1); tk.w = __builtin_bit_cast(unsigned, g2); TOPK[m] = tk;
                    atomicAdd((int*)(LC + e1), 1); atomicAdd((int*)(LC + e2), 1); }
            }
            __syncthreads();
            if (tid < 8) CNT[blk * 8 + tid] = LC[tid];
            __syncthreads();
        }
        if (BOTH(9)) GRID_BAR();
    }

    if (IN(10)) {
        PHASE_IDS(); KARG(kp); unsigned char* ws = KWS(kp);
        v4u* TOPK = (v4u*)(ws + WS_TOPK); int* CNT = (int*)(ws + WS_CNT); int* STOK = (int*)(ws + WS_STOK); int* SSLOT = (int*)(ws + WS_SSLOT); float* SGATE = (float*)(ws + WS_SGATE); int* TINFO = (int*)(ws + WS_TINFO);
        LAS int* LCNT = (LAS int*)(lds + RING_OFF);
        LAS int* LE = LCNT + 2048;
        LAS float* LG = (LAS float*)(LE + 256);
        LAS int* LT = (LAS int*)(LG + 256);
        for (int blk = bid; blk < NTOK / 128; blk += G) {
            for (int i = tid; i < 2048; i += NWAVES * 64) LCNT[i] = CNT[i];
            if (tid < 128) { const v4u tk = TOPK[blk * 128 + tid]; const unsigned tz = tk.z, tw = tk.w;
                LE[2 * tid] = (int)tk.x; LE[2 * tid + 1] = (int)tk.y; LG[2 * tid] = __uint_as_float(tz); LG[2 * tid + 1] = __uint_as_float(tw); }
            __syncthreads();
            if (tid < 8) { int t = 0, p = 0; for (int b2 = 0; b2 < 256; ++b2) { const int c = LCNT[b2 * 8 + tid]; if (b2 < blk) p += c; t += c; } LT[tid] = t; LT[8 + tid] = p; }
            __syncthreads();
            if (tid < 8) {
                const int e = tid; int base = 0;
                for (int e2 = 0; e2 < e; ++e2) base += (LT[e2] + 255) & ~255;
                int pos = base + LT[8 + e];
                for (int i = 0; i < 256; ++i) if (LE[i] == e) { STOK[pos] = blk * 128 + (i >> 1); SSLOT[pos] = 2 * (blk * 128) + i; SGATE[pos] = LG[i]; ++pos; }
                if (blk == 0) {
                    const int tot = LT[e], padded = (tot + 255) & ~255;
                    for (int q = base + tot; q < base + padded; ++q) { STOK[q] = 0; SSLOT[q] = -1; SGATE[q] = 0.f; }
                    TINFO[1 + e] = base >> 8;
                    if (e == 7) { TINFO[9] = (base + padded) >> 8; TINFO[0] = (base + padded) >> 8; }
                }
            }
            __syncthreads();
        }
        if (BOTH(10)) GRID_BAR();
    }

    for (int ch = 0; ch < NCHUNK; ++ch) {
        const int pu = 11 + 2 * ch, pd = 12 + 2 * ch;
        if (IN(pu)) {
            KARG(kp); unsigned char* ws = KWS(kp); const int* TINFO = (const int*)(ws + WS_TINFO);
            int ti[10];
#pragma unroll
            for (int j = 0; j < 10; ++j) ti[j] = __builtin_amdgcn_readfirstlane(TINFO[j]);
            const int tile0 = ch * CHUNK_TILES; int nM = ti[0] - tile0; if (nM > CHUNK_TILES) nM = CHUNK_TILES;
            if (nM > 0) {
                pg8::GSched S{}; S.so.init(nM * 256, 2 * EDIM, G, bid); S.A = (const char*)(ws + WS_SLOTA); S.a_pm = 0; S.a_pn = 0; S.B = (const char*)(ws + WS_WM1); S.b_pn = 256 * 1024 * 2; S.b_e = 7168 * 1024 * 2;
#pragma unroll
                for (int j = 0; j < 9; ++j) S.tb[j] = ti[1 + j];
                S.rowidx = (const int*)(ws + WS_STOK); S.pm0 = tile0;
                pg8::EpiSwiGLU<false> E{(bf16*)(ws + WS_HIDS), EDIM, nullptr};
                pg8::gemm_phase2<pg8::EpiSwiGLU<false>, true, true>(lds + RING_OFF, S, 1024, 1024, 1024, E);
            }
            if (BOTH(pu)) GRID_BAR();
        }
        if (IN(pd)) {
            KARG(kp); unsigned char* ws = KWS(kp); const int* TINFO = (const int*)(ws + WS_TINFO);
            int ti[10];
#pragma unroll
            for (int j = 0; j < 10; ++j) ti[j] = __builtin_amdgcn_readfirstlane(TINFO[j]);
            const int tile0 = ch * CHUNK_TILES; int nM = ti[0] - tile0; if (nM > CHUNK_TILES) nM = CHUNK_TILES;
            if (nM > 0) {
                pg8::GSched S{}; S.so.init(nM * 256, 1024, G, bid); S.A = (const char*)(ws + WS_HIDS); S.a_pm = 256 * EDIM * 2; S.a_pn = 0; S.B = (const char*)(ws + WS_WM2); S.b_pn = 256 * EDIM * 2; S.b_e = 1024 * EDIM * 2;
#pragma unroll
                for (int j = 0; j < 9; ++j) S.tb[j] = ti[1 + j];
                S.rowidx = nullptr; S.pm0 = tile0;
                pg8::EpiScatter E{(bf16*)(ws + WS_Y), (const int*)(ws + WS_SSLOT), (const float*)(ws + WS_SGATE), tile0};
                pg8::gemm_phase2<pg8::EpiScatter, false, true>(lds + RING_OFF, S, EDIM, EDIM, EDIM, E);
            }
            if (BOTH(pd)) GRID_BAR();
        }
    }

    if (IN(PH_FINAL)) {
        PHASE_IDS(); KARG(kp); unsigned char* ws = KWS(kp); float* H = KOUT(kp); const float* final_g = KIN(kp, 28); bf16* YB = (bf16*)(ws + WS_Y);
        unsigned poison = __hip_atomic_load(ctl + CW_BAR + XB_TMO, RLX_AGENT);
        for (int m = gw; m < NTOK; m += NGW) {
            GAS f32x4* xr = (GAS f32x4*)(H + (size_t)m * DMODEL) + lane;
            const GAS unsigned long long* y0 = (const GAS unsigned long long*)(YB + (size_t)(2 * m) * DMODEL) + lane;
            const GAS unsigned long long* y1 = (const GAS unsigned long long*)(YB + (size_t)(2 * m + 1) * DMODEL) + lane;
            f32x4 v[4]; float s = 0.f;
#pragma unroll
            for (int j = 0; j < 4; ++j) { v[j] = xr[64 * j]; const unsigned long long a = y0[64 * j], b = y1[64 * j];
                const unsigned a0 = (unsigned)a, a1 = (unsigned)(a >> 32), b0 = (unsigned)b, b1 = (unsigned)(b >> 32);
                v[j].x += __builtin_bit_cast(float, a0 << 16) + __builtin_bit_cast(float, b0 << 16);
                v[j].y += __builtin_bit_cast(float, a0 & 0xffff0000u) + __builtin_bit_cast(float, b0 & 0xffff0000u);
                v[j].z += __builtin_bit_cast(float, a1 << 16) + __builtin_bit_cast(float, b1 << 16);
                v[j].w += __builtin_bit_cast(float, a1 & 0xffff0000u) + __builtin_bit_cast(float, b1 & 0xffff0000u);
                s += (v[j].x * v[j].x + v[j].y * v[j].y) + (v[j].z * v[j].z + v[j].w * v[j].w); }
            float rstd = 1.0f / sqrtf(wave_sum(s) * (1.f / DMODEL) + 1e-6f);
            if (poison) rstd = __builtin_nanf("");
#pragma unroll
            for (int j = 0; j < 4; ++j) { const f32x4 g = *(const f32x4*)(final_g + 4 * (lane + 64 * j)); xr[64 * j] = v[j] * rstd * g; }
        }
    }
#undef IN
#undef BOTH
#undef GRID_BAR
}


__global__ void __launch_bounds__(512) diag_kernel(unsigned char* ws, float* out) {
    __shared__ int sh[4];
    const int* STOK = (const int*)(ws + WS_STOK); const int* TINFO = (const int*)(ws + WS_TINFO); const int* CNT = (const int*)(ws + WS_CNT); const int* SSLOT = (const int*)(ws + WS_SSLOT);
    if (threadIdx.x < 4) sh[threadIdx.x] = 0;
    __syncthreads();
    const int nt = TINFO[0];
    int bad = 0, badslot = 0;
    const int lim = (nt >= 0 && nt <= 264) ? nt * 256 : 0;
    for (int p = threadIdx.x; p < lim; p += 512) { const int v = STOK[p]; if (v < 0 || v >= 32768) bad++; const int sl = SSLOT[p]; if (sl < -1 || sl >= 65536) badslot++; }
    int tot = 0; for (int i = threadIdx.x; i < 2048; i += 512) tot += CNT[i];
    atomicAdd(&sh[0], bad); atomicAdd(&sh[1], tot); atomicAdd(&sh[2], badslot);
    __syncthreads();
    int code = 1;
    if (nt < 256 || nt > 264) code += 1;
    if (sh[1] != 65536) code += 2;
    if (sh[0] > 0) code += 4;
    if (sh[2] > 0) code += 8;
    const float v = sqrtf((float)code);
    for (size_t i = (size_t)blockIdx.x * 512 + threadIdx.x; i < (size_t)NTOK * DMODEL; i += (size_t)gridDim.x * 512) out[i] = v;
}


__global__ void __launch_bounds__(512) diag2a(unsigned char* ws) {
    const bf16* W2 = (const bf16*)(ws + WS_WM2); const float* SG = (const float*)(ws + WS_SGATE); float* accs = (float*)(ws + 65536);
    float sy = 0.f, sh = 0.f;
    for (size_t i = (size_t)blockIdx.x * 512 + threadIdx.x; i < (size_t)8 * 1024 * 3584; i += (size_t)gridDim.x * 512) { const float v = bf2f(W2[i]) * 60.f; sy += (v == v && fabsf(v) < 1e4f) ? v * v : 1e8f; }
    for (size_t i = (size_t)blockIdx.x * 512 + threadIdx.x; i < (size_t)65536; i += (size_t)gridDim.x * 512) { const float v = SG[i]; sh += (v == v && fabsf(v) < 1e4f) ? v * v : 1e8f; }
    sy = wave_sum(sy); sh = wave_sum(sh);
    if ((threadIdx.x & 63) == 0) { atomicAdd(accs, sy); atomicAdd(accs + 1, sh); }
}
__global__ void __launch_bounds__(512) diag2b(unsigned char* ws, float* out) {
    const float* accs = (const float*)(ws + 65536);
    const float ry = 0.5f * sqrtf(accs[0] / (8.f * 1024.f * 3584.f)), rh = sqrtf(accs[1] / 65536.f);
    int A = (int)(10.f * ry + 0.5f); if (A > 9) A = 9; int B = (int)(10.f * rh + 0.5f); if (B > 9) B = 9;
    const float v = sqrtf((float)(1 + A + 10 * B));
    for (size_t i = (size_t)blockIdx.x * 512 + threadIdx.x; i < (size_t)NTOK * DMODEL; i += (size_t)gridDim.x * 512) out[i] = v;
}

#ifndef MK_MAXPH
#define MK_MAXPH PH_END
#endif
#ifndef MK_PER_PHASE
#define MK_PER_PHASE 1
#endif
extern "C" void kernel_launch(void* const* d_in, const int* in_sizes, int n_in, void* d_out, int out_size, void* d_ws, size_t ws_size, hipStream_t stream) {
    static int grid = 0;
    if (grid == 0) {
        if (n_in != 29 || in_sizes[0] != NTOK * DMODEL || out_size != NTOK * DMODEL || ws_size < WS_END) { fprintf(stderr, "kernel_launch: unexpected shapes / workspace (%d inputs, ws %zu); nothing launched\n", n_in, ws_size); grid = -1; return; }
        int dev = 0, cus = 0, per_cu = 0;
        if (hipGetDevice(&dev) != hipSuccess || hipDeviceGetAttribute(&cus, hipDeviceAttributeMultiprocessorCount, dev) != hipSuccess) { grid = -1; return; }
        if (hipFuncSetAttribute((const void*)mk_fwd, hipFuncAttributeMaxDynamicSharedMemorySize, LDS_BYTES) != hipSuccess) { fprintf(stderr, "kernel_launch: hipFuncSetAttribute failed\n"); grid = -1; return; }
        if (hipOccupancyMaxActiveBlocksPerMultiprocessor(&per_cu, (const void*)mk_fwd, NWAVES * 64, LDS_BYTES) != hipSuccess || per_cu < 1) { fprintf(stderr, "kernel_launch: occupancy query reports %d\n", per_cu); }
        (void)hipGetLastError();
        grid = cus;
    }
    if (grid < 0) return;
    if (hipMemsetAsync((char*)d_ws + WS_CTL, 0, CTL_ZERO_BYTES, stream) != hipSuccess) return;
    Args a{};
    for (int i = 0; i < 29; ++i) a.in[i] = (const float*)d_in[i];
    a.out = (float*)d_out; a.ws = (unsigned char*)d_ws;
#if MK_PER_PHASE
    for (int p = 0; p < MK_MAXPH; ++p) { a.ph_lo = p; a.ph_hi = p + 1; hipLaunchKernelGGL(mk_fwd, dim3(grid), dim3(NWAVES * 64), LDS_BYTES, stream, a); }
#ifdef MK_DIAG
    hipLaunchKernelGGL(diag2a, dim3(256), dim3(512), 0, stream, (unsigned char*)d_ws);
    hipLaunchKernelGGL(diag2b, dim3(256), dim3(512), 0, stream, (unsigned char*)d_ws, (float*)d_out);
#endif
#else
    a.ph_lo = 0; a.ph_hi = PH_END; hipLaunchKernelGGL(mk_fwd, dim3(grid), dim3(NWAVES * 64), LDS_BYTES, stream, a);
#endif
}
```

```cpp
#include <hip/hip_runtime.h>
#include <hip/hip_bf16.h>
#include <cstdio>
#include <cstdint>
#include <cmath>
namespace pg8 {
#define PG8_LAS __attribute__((address_space(3)))
typedef unsigned short bf16_t;
typedef short bf16x8 __attribute__((ext_vector_type(8)));
typedef float f32x4 __attribute__((ext_vector_type(4)));
typedef unsigned u32x4 __attribute__((ext_vector_type(4)));
typedef unsigned u32x2 __attribute__((ext_vector_type(2)));
typedef float f32x2 __attribute__((ext_vector_type(2)));
typedef int i32x4 __attribute__((ext_vector_type(4)));
typedef int i32x8 __attribute__((ext_vector_type(8)));
constexpr int BM = 256, BK = 64, HALF = 128, HTB = HALF * BK * 2  , STAGE_BYTES = 8 * HTB, NXCD = 8, WGM = 4;

__host__ __device__ __forceinline__ int lds_byte(int r, int c) { const int st = (r >> 4) * 2 + (c >> 5), rr = r & 15, cc = c & 31, ob = rr * 64 + cc * 2; return st * 1024 + (ob ^ (((ob >> 9) & 1) << 5)); }
__host__ __device__ __forceinline__ void stage_rc(int b, int& R, int& C) { const int st = b / 1024, sb = b % 1024, swz = sb ^ (((sb >> 9) & 1) << 5); R = (st >> 1) * 16 + swz / 64; C = (st & 1) * 32 + (swz % 64) / 2; }
__host__ __device__ __forceinline__ int perm32(int rho) { const int n = rho >> 4, i = rho & 15; return 8 * (i >> 2) + 4 * n + (i & 3); }

struct Unit { int pm, pn; };

struct StaticOrder {
    int nM, nN, nwg, G, c;
    __host__ __device__ void init(int M, int N, int G_, int c_) { nM = M / BM; nN = N / BM; nwg = nM * nN; G = G_; c = c_; }
    __host__ __device__ bool next(int i, Unit& u) const {
        const long L = (long)i * G + c; if (L >= nwg) return false;
        int wgid = (int)L; { const int q = nwg / NXCD, r = nwg % NXCD, xcd = wgid % NXCD, off = wgid / NXCD; wgid = (xcd < r ? xcd * (q + 1) : r * (q + 1) + (xcd - r) * q) + off; }
        const int nig = WGM * nN, gid = wgid / nig, fm = gid * WGM, gsz = (nM - fm) < WGM ? (nM - fm) : WGM;
        u.pm = fm + ((wgid % nig) % gsz); u.pn = (wgid % nig) / gsz; return true;
    }
};
struct GSched {
    StaticOrder so;
    const char* A; unsigned a_pm, a_pn;
    const char* B; unsigned b_pn, b_e;
    int tb[9];
    const int* rowidx; int pm0;
    __device__ __forceinline__ bool next(int i, Unit& u) const { return so.next(i, u); }
    __device__ __forceinline__ const char* a_ptr(const Unit& u) const { return A + (size_t)u.pm * a_pm + (size_t)u.pn * a_pn; }
    __device__ __forceinline__ const char* b_ptr(const Unit& u) const {
        size_t off = (size_t)u.pn * b_pn;
        if (b_e) { const int t = pm0 + u.pm; int e = 0;
#pragma unroll
            for (int j = 1; j < 8; ++j) e += (t >= tb[j]) ? 1 : 0;
            off += (size_t)e * b_e; }
        return B + off;
    }
};

__device__ __forceinline__ unsigned cvt_pk_bf16(float lo, float hi) { unsigned r; asm volatile("v_cvt_pk_bf16_f32 %0, %1, %2" : "=v"(r) : "v"(lo), "v"(hi)); return r; }

constexpr float C2 = 0.125f * 1.4426950408889634f;

struct EpiInProj {
    static constexpr bool PERM = true;
    bf16_t* O; const float* rope;
    __device__ __forceinline__ void operator()(const f32x4 (&acc)[2][2][4][2], const Unit& u, int wr, int wc, int fr, int fq) const {
        const int row0 = u.pm * BM + wr * 64 + fr, col0 = u.pn * BM + wc * 32 + 8 * fq;
        const float sc = (u.pn < 2) ? C2 : 1.f;
        const bool ropew = (u.pn < 4) && ((wc & 1) == 0);
        const float sgn = (fq == 0) ? -1.f : 1.f;
#pragma unroll
        for (int ai = 0; ai < 2; ++ai)
#pragma unroll
            for (int m = 0; m < 4; ++m) {
                const int row = row0 + ai * HALF + m * 16; bf16_t* rowp = O + (size_t)row * 2560 + col0;
                f32x4 cs[4];
                if (ropew) { const f32x4* tp = (const f32x4*)(rope + (size_t)(row & 4095) * 16); cs[0] = tp[0]; cs[1] = tp[1]; cs[2] = tp[2]; cs[3] = tp[3]; }
#pragma unroll
                for (int bj = 0; bj < 2; ++bj) {
                    f32x4 v0 = acc[ai][bj][m][0], v1 = acc[ai][bj][m][1];
                    if (ropew) {
                        f32x4 p0, p1;
#pragma unroll
                        for (int j = 0; j < 4; ++j) { p0[j] = __shfl_xor(v0[j], 16); p1[j] = __shfl_xor(v1[j], 16); }
                        if (fq < 2) {
                            v0[0] = v0[0] * cs[0][0] + sgn * p0[0] * cs[0][1]; v0[1] = v0[1] * cs[0][2] + sgn * p0[1] * cs[0][3];
                            v0[2] = v0[2] * cs[1][0] + sgn * p0[2] * cs[1][1]; v0[3] = v0[3] * cs[1][2] + sgn * p0[3] * cs[1][3];
                            v1[0] = v1[0] * cs[2][0] + sgn * p1[0] * cs[2][1]; v1[1] = v1[1] * cs[2][2] + sgn * p1[1] * cs[2][3];
                            v1[2] = v1[2] * cs[3][0] + sgn * p1[2] * cs[3][1]; v1[3] = v1[3] * cs[3][2] + sgn * p1[3] * cs[3][3];
                        }
                    }
                    v0 = v0 * sc; v1 = v1 * sc;
                    u32x4 w; w.x = cvt_pk_bf16(v0[0], v0[1]); w.y = cvt_pk_bf16(v0[2], v0[3]); w.z = cvt_pk_bf16(v1[0], v1[1]); w.w = cvt_pk_bf16(v1[2], v1[3]);
                    *(u32x4*)(rowp + bj * HALF) = w;
                }
            }
    }
};
__device__ __forceinline__ unsigned cvt4_fp8(float a, float b, float c, float d);
template <bool BF16OUT, bool F32OUT, bool BF16RES, bool FP8OUT = false, bool ROWSCALE = false> struct EpiResid {
    static constexpr bool PERM = false;
    const float* res; const bf16_t* resb; float* out; bf16_t* ob; float* ssq; unsigned char* oq; const float* rsc;
    __device__ __forceinline__ void operator()(const f32x4 (&acc)[2][2][4][2], const Unit& u, int wr, int wc, int fr, int fq) const {
        const int row0 = u.pm * BM + wr * 64 + fr, col0 = u.pn * BM + wc * 32 + 4 * fq;
#pragma unroll
        for (int ai = 0; ai < 2; ++ai)
#pragma unroll
            for (int m = 0; m < 4; ++m) {
                const int row = row0 + ai * HALF + m * 16; const size_t off = (size_t)row * 1024 + col0; float ss = 0.f; float rsv = 1.f;
                if (ROWSCALE) rsv = rsc[row];
#pragma unroll
                for (int bj = 0; bj < 2; ++bj)
#pragma unroll
                    for (int n = 0; n < 2; ++n) {
                        const size_t o = off + bj * HALF + n * 16;
                        f32x4 r;
                        if (BF16RES) { const u32x2 rb = *(const u32x2*)(resb + o); r[0] = __uint_as_float(rb.x << 16); r[1] = __uint_as_float(rb.x & 0xffff0000u); r[2] = __uint_as_float(rb.y << 16); r[3] = __uint_as_float(rb.y & 0xffff0000u); if (ROWSCALE) r = r * rsv; }
                        else r = *(const f32x4*)(res + o);
                        const f32x4 v = acc[ai][bj][m][n] + r;
                        if (F32OUT) *(f32x4*)(out + o) = v;
                        ss += (v[0] * v[0] + v[1] * v[1]) + (v[2] * v[2] + v[3] * v[3]);
                        if (BF16OUT) { u32x2 w; w.x = cvt_pk_bf16(v[0], v[1]); w.y = cvt_pk_bf16(v[2], v[3]); *(u32x2*)(ob + o) = w; }
                        if (FP8OUT) *(unsigned*)(oq + o) = cvt4_fp8(v[0] * 4.f, v[1] * 4.f, v[2] * 4.f, v[3] * 4.f);
                    }
                ss += __shfl_xor(ss, 16); ss += __shfl_xor(ss, 32);
                if (fq == 0) ssq[(size_t)row * 16 + u.pn * 4 + wc] = ss;
                if (m & 1) asm volatile("" ::: "memory");
            }
    }
};
template <bool RSTD> struct EpiSwiGLU {
    static constexpr bool PERM = true;
    bf16_t* O; int ldc; const float* ssq;
    __device__ __forceinline__ void operator()(const f32x4 (&acc)[2][2][4][2], const Unit& u, int wr, int wc, int fr, int fq) const {
        const int row0 = u.pm * BM + wr * 64 + fr, col0 = u.pn * HALF + wc * 32 + 8 * fq;
#pragma unroll
        for (int ai = 0; ai < 2; ++ai)
#pragma unroll
            for (int m = 0; m < 4; ++m) {
                const int row = row0 + ai * HALF + m * 16; float rs = 1.f;
                if (RSTD) { const f32x4* sp = (const f32x4*)(ssq + (size_t)row * 16); const f32x4 a = sp[0], b = sp[1], c = sp[2], d = sp[3];
                    const f32x4 t = (a + b) + (c + d); rs = __builtin_amdgcn_rsqf(((t[0] + t[1]) + (t[2] + t[3])) * (1.0f / 1024.0f) + 1e-6f); }
                float h[8];
#pragma unroll
                for (int n = 0; n < 2; ++n)
#pragma unroll
                    for (int j = 0; j < 4; ++j) { const float g = acc[ai][0][m][n][j] * rs, up = acc[ai][1][m][n][j] * rs;
                        h[n * 4 + j] = g * __builtin_amdgcn_rcpf(1.0f + __expf(-g)) * up; }
                u32x4 w; w.x = cvt_pk_bf16(h[0], h[1]); w.y = cvt_pk_bf16(h[2], h[3]); w.z = cvt_pk_bf16(h[4], h[5]); w.w = cvt_pk_bf16(h[6], h[7]);
                *(u32x4*)(O + (size_t)row * ldc + col0) = w;
            }
    }
};
__device__ __forceinline__ unsigned cvt4_fp8(float a, float b, float c, float d) {
    a = __builtin_amdgcn_fmed3f(a, -448.f, 448.f); b = __builtin_amdgcn_fmed3f(b, -448.f, 448.f); c = __builtin_amdgcn_fmed3f(c, -448.f, 448.f); d = __builtin_amdgcn_fmed3f(d, -448.f, 448.f);
    int w = 0; w = __builtin_amdgcn_cvt_pk_fp8_f32(a, b, w, false); w = __builtin_amdgcn_cvt_pk_fp8_f32(c, d, w, true); return (unsigned)w;
}
template <bool RSTD> struct EpiSwiGLU8T {
    static constexpr bool PERM = true;
    unsigned char* O; int ldc; float oscale; const float* ssq;
    __device__ __forceinline__ void operator()(const f32x4 (&acc)[2][2][4][2], const Unit& u, int wr, int wc, int fr, int fq) const {
        const int row0 = u.pm * BM + wr * 64 + fr, col0 = u.pn * HALF + wc * 32 + 8 * fq;
#pragma unroll
        for (int ai = 0; ai < 2; ++ai)
#pragma unroll
            for (int m = 0; m < 4; ++m) {
                const int row = row0 + ai * HALF + m * 16; float h[8]; float rs = 1.f;
                if (RSTD) { const f32x4* sp = (const f32x4*)(ssq + (size_t)row * 16); const f32x4 a = sp[0], b = sp[1], c = sp[2], d = sp[3];
                    const f32x4 t = (a + b) + (c + d); rs = __builtin_amdgcn_rsqf(((t[0] + t[1]) + (t[2] + t[3])) * (1.0f / 1024.0f) + 1e-6f); }
                const float us = rs * oscale;
#pragma unroll
                for (int n = 0; n < 2; ++n)
#pragma unroll
                    for (int jp = 0; jp < 2; ++jp) {
                        f32x2 g2 = (f32x2){acc[ai][0][m][n][2 * jp], acc[ai][0][m][n][2 * jp + 1]}, u2 = (f32x2){acc[ai][1][m][n][2 * jp], acc[ai][1][m][n][2 * jp + 1]};
                        if (RSTD) g2 = g2 * rs;
                        u2 = u2 * us;
                        const f32x2 t2 = g2 * (-1.4426950408889634f);
                        f32x2 d2; d2.x = __builtin_amdgcn_exp2f(t2.x); d2.y = __builtin_amdgcn_exp2f(t2.y);
                        d2 = d2 + 1.0f;
                        f32x2 r2; r2.x = __builtin_amdgcn_rcpf(d2.x); r2.y = __builtin_amdgcn_rcpf(d2.y);
                        const f32x2 h2 = (g2 * r2) * u2;
                        h[n * 4 + 2 * jp] = h2.x; h[n * 4 + 2 * jp + 1] = h2.y; }
                u32x2 w; w.x = cvt4_fp8(h[0], h[1], h[2], h[3]); w.y = cvt4_fp8(h[4], h[5], h[6], h[7]);
                *(u32x2*)(O + (size_t)row * ldc + col0) = w;
            }
    }
};
typedef EpiSwiGLU8T<false> EpiSwiGLU8;
struct EpiPool {
    static constexpr bool PERM = false;
    bf16_t* H; const float* scale;
    __device__ __forceinline__ void operator()(const f32x4 (&acc)[2][2][4][2], const Unit& u, int wr, int wc, int fr, int fq) const {
        const int row0 = u.pm * BM + wr * 64 + fr, col0 = u.pn * BM + wc * 32 + 4 * fq;
        f32x4 sv[2][2];
#pragma unroll
        for (int bj = 0; bj < 2; ++bj)
#pragma unroll
            for (int n = 0; n < 2; ++n) sv[bj][n] = *(const f32x4*)(scale + col0 + bj * HALF + n * 16);
#pragma unroll
        for (int ai = 0; ai < 2; ++ai)
#pragma unroll
            for (int m = 0; m < 4; ++m) {
                const size_t off = (size_t)(row0 + ai * HALF + m * 16) * 1024 + col0;
#pragma unroll
                for (int bj = 0; bj < 2; ++bj)
#pragma unroll
                    for (int n = 0; n < 2; ++n) { const size_t o = off + bj * HALF + n * 16; const u32x2 rb = *(const u32x2*)(H + o); f32x4 r; r[0] = __uint_as_float(rb.x << 16); r[1] = __uint_as_float(rb.x & 0xffff0000u); r[2] = __uint_as_float(rb.y << 16); r[3] = __uint_as_float(rb.y & 0xffff0000u);
                        const f32x4 v = r + acc[ai][bj][m][n] * sv[bj][n]; u32x2 w; w.x = cvt_pk_bf16(v[0], v[1]); w.y = cvt_pk_bf16(v[2], v[3]); *(u32x2*)(H + o) = w; }
                if (m & 1) asm volatile("" ::: "memory");
            }
    }
};
struct EpiScatter {
    static constexpr bool PERM = true;
    unsigned char* Y; const int* slot; const float* gate; int pm0;
    __device__ __forceinline__ void operator()(const f32x4 (&acc)[2][2][4][2], const Unit& u, int wr, int wc, int fr, int fq) const {
        const int pos0 = (pm0 + u.pm) * BM + wr * 64 + fr, col0 = u.pn * BM + wc * 32 + 8 * fq;
#pragma unroll
        for (int ai = 0; ai < 2; ++ai)
#pragma unroll
            for (int m = 0; m < 4; ++m) {
                const int pos = pos0 + ai * HALF + m * 16; const int s = slot[pos]; const float g = gate[pos] * 16.0f;
                if (s >= 0) {
#pragma unroll
                    for (int bj = 0; bj < 2; ++bj) { const f32x4 v0 = acc[ai][bj][m][0] * g, v1 = acc[ai][bj][m][1] * g;
                        u32x2 w; w.x = cvt4_fp8(v0[0], v0[1], v0[2], v0[3]); w.y = cvt4_fp8(v1[0], v1[1], v1[2], v1[3]);
                        *(u32x2*)(Y + (size_t)s * 1024 + col0 + bj * HALF) = w; }
                }
            }
    }
};

template <class Epi, bool GATHER, bool ALIGN_EPI, bool FP8 = false>
__device__ __forceinline__ void gemm_phase2(PG8_LAS unsigned char* lds, const GSched& S, const int K, const int lda, const int ldb, const Epi& E, const int scale_w = 127, const int scale_a = 127) {
    int tid_ = threadIdx.x; asm volatile("" : "+v"(tid_));
    const int tid = tid_, wid = __builtin_amdgcn_readfirstlane(tid >> 6), lane = tid & 63, wr = wid >> 2, wc = wid & 3, fr = lane & 15, fq = lane >> 4;
    const int nt = K / BK;
    int Rr[2], Cc[2]; unsigned voffB[2], voA[2][2], nvoA[2][2];
#pragma unroll
    for (int i = 0; i < 2; ++i) { stage_rc(tid * 16 + i * 8192, Rr[i], Cc[i]); const int Rb = Epi::PERM ? ((Rr[i] & ~31) + perm32(Rr[i] & 31)) : Rr[i];
        voffB[i] = (unsigned)(Rb * ldb + Cc[i]) * 2u;
#pragma unroll
        for (int h = 0; h < 2; ++h) { voA[h][i] = (unsigned)((Rr[i] + h * HALF) * lda + Cc[i]) * 2u; nvoA[h][i] = voA[h][i]; } }
    const size_t kstep = (size_t)(BK * 2);
    const size_t hstepB = (size_t)HALF * ldb * 2;
    const unsigned ldsw = (unsigned)wid * 1024u;
    const int aoff = lds_byte(wr * 64 + fr, fq * (FP8 ? 16 : 8)) + (FP8 ? 16 * (fq & 1) : 0), boff = lds_byte(wc * 32 + fr, fq * (FP8 ? 16 : 8)) + (FP8 ? 16 * (fq & 1) : 0);
    const int aoff2 = aoff ^ 16, boff2 = boff ^ 16;
#define PG8_SA(b, h) (((b) * 2 + (h)) * HTB)
#define PG8_SB(b, h) ((4 + (b) * 2 + (h)) * HTB)
#define PG8_STAGE(bufoff, gbase, voff) do { _Pragma("unroll") for (int _i = 0; _i < 2; ++_i) \
        __builtin_amdgcn_global_load_lds((const unsigned*)((const char*)(gbase) + (voff)[_i]), (PG8_LAS unsigned*)(lds + (bufoff) + ldsw + _i * 8192), 16, 0, 0); } while (0)
#define PG8_CAT(x, y) __builtin_shufflevector((x), (y), 0, 1, 2, 3, 4, 5, 6, 7)
#define PG8_LDA(dst, b, h) do { if constexpr (FP8) { _Pragma("unroll") for (int m = 0; m < 4; ++m) dst##8[m] = PG8_CAT(*(const PG8_LAS i32x4*)(lds + PG8_SA(b, h) + aoff + m * 2048), *(const PG8_LAS i32x4*)(lds + PG8_SA(b, h) + aoff2 + m * 2048)); } \
        else { _Pragma("unroll") for (int m = 0; m < 4; ++m) _Pragma("unroll") for (int k = 0; k < 2; ++k) dst[m][k] = *(const PG8_LAS bf16x8*)(lds + PG8_SA(b, h) + aoff + m * 2048 + k * 1024); } } while (0)
#define PG8_LDB(dst, b, h) do { if constexpr (FP8) { _Pragma("unroll") for (int n = 0; n < 2; ++n) dst##8[n] = PG8_CAT(*(const PG8_LAS i32x4*)(lds + PG8_SB(b, h) + boff + n * 2048), *(const PG8_LAS i32x4*)(lds + PG8_SB(b, h) + boff2 + n * 2048)); } \
        else { _Pragma("unroll") for (int n = 0; n < 2; ++n) _Pragma("unroll") for (int k = 0; k < 2; ++k) dst[n][k] = *(const PG8_LAS bf16x8*)(lds + PG8_SB(b, h) + boff + n * 2048 + k * 1024); } } while (0)
#define PG8_MMA(ai, bj, At, Bt) do { __builtin_amdgcn_s_setprio(1); _Pragma("unroll") for (int m = 0; m < 4; ++m) _Pragma("unroll") for (int n = 0; n < 2; ++n) { \
        if constexpr (FP8) asm volatile("v_mfma_scale_f32_16x16x128_f8f6f4 %0, %1, %2, %0, %3, %4 op_sel_hi:[0,0,0]" : "+v"(acc[ai][bj][m][n]) : "v"(Bt##8[n]), "v"(At##8[m]), "v"(scale_w), "v"(scale_a)); \
        else { _Pragma("unroll") for (int k = 0; k < 2; ++k) acc[ai][bj][m][n] = __builtin_amdgcn_mfma_f32_16x16x32_bf16(Bt[n][k], At[m][k], acc[ai][bj][m][n], 0, 0, 0); } } \
        __builtin_amdgcn_s_setprio(0); } while (0)
#define PG8_WAIT_V(n) asm volatile("s_waitcnt vmcnt(" #n ")" ::: "memory")
#define PG8_WAIT_L(n) asm volatile("s_waitcnt lgkmcnt(" #n ")" ::: "memory")
#define PG8_BAR __builtin_amdgcn_s_barrier()
#define PG8_SCHED __builtin_amdgcn_sched_barrier(0)
#define PG8_GIDX(dst, u) do { if constexpr (GATHER) { _Pragma("unroll") for (int _h = 0; _h < 2; ++_h) _Pragma("unroll") for (int _i = 0; _i < 2; ++_i) \
        dst[_h][_i] = (unsigned)S.rowidx[(S.pm0 + (u).pm) * BM + _h * HALF + Rr[_i]] * (unsigned)(lda * 2) + (unsigned)(Cc[_i] * 2); } } while (0)
    Unit cur, nxt; int ui = 0;
    if (!S.next(0, cur)) return;
    f32x4 acc[2][2][4][2];
#pragma unroll
    for (int a = 0; a < 2; ++a)
#pragma unroll
        for (int b = 0; b < 2; ++b)
#pragma unroll
            for (int m = 0; m < 4; ++m)
#pragma unroll
                for (int n = 0; n < 2; ++n) acc[a][b][m][n] = (f32x4){0.f, 0.f, 0.f, 0.f};
    bf16x8 At[4][2], B0[2][2], B1[2][2];
    i32x8 At8[4], B08[2], B18[2];
    (void)At; (void)B0; (void)B1; (void)At8; (void)B08; (void)B18; (void)aoff2; (void)boff2;
    const char* cA = S.a_ptr(cur); const char* cB = S.b_ptr(cur);
    PG8_GIDX(voA, cur);
    PG8_STAGE(PG8_SB(0, 0), cB, voffB); PG8_STAGE(PG8_SB(0, 1), cB + hstepB, voffB); PG8_STAGE(PG8_SA(0, 0), cA, voA[0]); PG8_STAGE(PG8_SA(0, 1), cA, voA[1]);
    if (wr == 1) PG8_BAR;
    PG8_WAIT_V(2); PG8_BAR;
    PG8_STAGE(PG8_SB(1, 0), cB + kstep, voffB); PG8_STAGE(PG8_SA(1, 0), cA + kstep, voA[0]); PG8_STAGE(PG8_SB(1, 1), cB + hstepB + kstep, voffB);
    PG8_WAIT_V(6); PG8_BAR;
    for (;;) {
        const bool has_next = S.next(ui + 1, nxt);
        const char* nA = has_next ? S.a_ptr(nxt) : cA; const char* nB = has_next ? S.b_ptr(nxt) : cB;
        if constexpr (GATHER) { if (has_next) { PG8_GIDX(nvoA, nxt); } else {
#pragma unroll
            for (int h = 0; h < 2; ++h)
#pragma unroll
                for (int i = 0; i < 2; ++i) nvoA[h][i] = voA[h][i]; } }
#pragma nounroll
        for (int t = 0; t < nt; t += 2) {
            const bool last = (t == nt - 2);
            const char* a1 = cA + (size_t)(t + 1) * kstep;
            const char* a2 = last ? nA : cA + (size_t)(t + 2) * kstep; const char* b2 = last ? nB : cB + (size_t)(t + 2) * kstep;
            const char* a3 = a2 + kstep; const char* b3 = b2 + kstep;
            if constexpr (GATHER) asm volatile("" : "+v"(voA[0][0]), "+v"(voA[0][1]), "+v"(voA[1][0]), "+v"(voA[1][1]));
            PG8_LDB(B0, 0, 0); PG8_LDB(B1, 0, 1); PG8_SCHED; PG8_LDA(At, 0, 0); PG8_STAGE(PG8_SA(1, 1), a1, voA[1]);
            PG8_WAIT_V(8); PG8_WAIT_L(0); PG8_BAR; PG8_MMA(0, 0, At, B0); PG8_MMA(0, 1, At, B1); PG8_BAR; PG8_SCHED;
            if constexpr (GATHER) { if (last) {
#pragma unroll
                for (int h = 0; h < 2; ++h)
#pragma unroll
                    for (int i = 0; i < 2; ++i) voA[h][i] = nvoA[h][i];
                asm volatile("" : "+v"(voA[0][0]), "+v"(voA[0][1]), "+v"(voA[1][0]), "+v"(voA[1][1])); } }
            PG8_LDA(At, 0, 1); PG8_STAGE(PG8_SB(0, 0), b2, voffB); PG8_STAGE(PG8_SB(0, 1), b2 + hstepB, voffB); PG8_STAGE(PG8_SA(0, 0), a2, voA[0]);
            PG8_WAIT_V(8); PG8_WAIT_L(0); PG8_BAR; PG8_MMA(1, 0, At, B0); PG8_MMA(1, 1, At, B1); PG8_BAR; PG8_SCHED;
            PG8_LDB(B0, 1, 0); PG8_LDB(B1, 1, 1); PG8_SCHED; PG8_LDA(At, 1, 0); PG8_STAGE(PG8_SA(0, 1), a2, voA[1]);
            PG8_WAIT_V(8); PG8_WAIT_L(0); PG8_BAR; PG8_MMA(0, 0, At, B0); PG8_MMA(0, 1, At, B1); PG8_BAR; PG8_SCHED;
            PG8_LDA(At, 1, 1); PG8_STAGE(PG8_SB(1, 0), b3, voffB); PG8_STAGE(PG8_SB(1, 1), b3 + hstepB, voffB); PG8_STAGE(PG8_SA(1, 0), a3, voA[0]);
            PG8_WAIT_V(8); PG8_WAIT_L(0); PG8_BAR; PG8_MMA(1, 0, At, B0); PG8_MMA(1, 1, At, B1); PG8_BAR; PG8_SCHED;
        }
        if constexpr (ALIGN_EPI) { if (wr == 0) PG8_BAR; }
        if constexpr (FP8) asm volatile("s_nop 15\n\ts_nop 15\n\ts_nop 7" ::: "memory");
        E(acc, cur, wr, wc, fr, fq);
        if (!has_next) break;
#pragma unroll
        for (int a = 0; a < 2; ++a)
#pragma unroll
            for (int b = 0; b < 2; ++b)
#pragma unroll
                for (int m = 0; m < 4; ++m)
#pragma unroll
                    for (int n = 0; n < 2; ++n) acc[a][b][m][n] = (f32x4){0.f, 0.f, 0.f, 0.f};
        cur = nxt; cA = nA; cB = nB; ++ui;
        if constexpr (ALIGN_EPI) { if (wr == 1) PG8_BAR; }
    }
    PG8_WAIT_V(0);
    if constexpr (!ALIGN_EPI) { if (wr == 0) PG8_BAR; }
    PG8_BAR;
#undef PG8_SA
#undef PG8_SB
#undef PG8_STAGE
#undef PG8_LDA
#undef PG8_LDB
#undef PG8_MMA
#undef PG8_CAT
#undef PG8_WAIT_V
#undef PG8_WAIT_L
#undef PG8_BAR
#undef PG8_SCHED
#undef PG8_GIDX
}
}
namespace attn_body {
using bf16=__hip_bfloat16;
using bf16x8=__attribute__((ext_vector_type(8)))short;
using s16x4=__attribute__((ext_vector_type(4)))short;
using f32x16=__attribute__((ext_vector_type(16)))float;
using u32x4=__attribute__((ext_vector_type(4)))unsigned;
constexpr int SEQ=4096,D=64,PQ=2560,PO=1024;
constexpr int NW=8,QBLK=32,QB=QBLK*NW,KVBLK=64,NQB=SEQ/QB;
constexpr int ATTN_UNIT_ROWS=QB;
__device__ __forceinline__ int crow(int r,int hi){return (r&3)+8*(r>>2)+4*hi;}
#define SBAR() __builtin_amdgcn_sched_barrier(0)
__device__ __forceinline__ void cmask(f32x16&p0,f32x16&p1,int jb,int qrel,int hi){
  const float NEG=-INFINITY; int kb=64*jb+4*hi;
  #pragma unroll
  for(int r=0;r<16;++r){int kv=kb+(r&3)+8*(r>>2); if(kv>qrel)p0[r]=NEG; if(kv+32>qrel)p1[r]=NEG;}
}

constexpr int NSLOT=3, SLOTB=8192;
constexpr int LDS_K=0, LDS_V=NSLOT*SLOTB, LDS_WS=2*NSLOT*SLOTB, LDS_OST=LDS_WS+NW*64*4, LDS_BYTES=LDS_OST+NW*4096;
constexpr float C2=0.125f*1.4426950408889634f;
__device__ __forceinline__ void glds16(const void*gsrc,unsigned lds_dst){unsigned keep;
  asm volatile("s_mov_b32 %0, m0\n\ts_mov_b32 m0, %2\n\ts_nop 0\n\tglobal_load_lds_dwordx4 %1, off\n\ts_mov_b32 m0, %0":"=&s"(keep):"v"(gsrc),"s"(lds_dst):"memory");}
__device__ __forceinline__ float max3f(float a,float b,float c){float r;asm("v_max3_f32 %0, %1, %2, %3":"=v"(r):"v"(a),"v"(b),"v"(c));return r;}
__device__ __forceinline__ float max2f(float a,float b){float r;asm("v_max_f32_e32 %0, %1, %2":"=v"(r):"v"(a),"v"(b));return r;}
__device__ __forceinline__ float fadd_s(float a,float b){float r;asm("v_add_f32_e32 %0, %1, %2":"=v"(r):"v"(a),"v"(b));return r;}
__device__ __forceinline__ float fsub_s(float a,float b){float r;asm("v_sub_f32_e32 %0, %1, %2":"=v"(r):"v"(a),"v"(b));return r;}
typedef float f32x2_t __attribute__((ext_vector_type(2))); typedef __bf16 bf16x2_t __attribute__((ext_vector_type(2)));
__device__ __forceinline__ unsigned cvtpk_s(float lo,float hi){f32x2_t v={lo,hi};bf16x2_t b=__builtin_convertvector(v,bf16x2_t);return __builtin_bit_cast(unsigned,b);}
#define WAIT_BAR(N) asm volatile("s_waitcnt vmcnt(" #N ") lgkmcnt(0)\n\ts_barrier":::"memory")

__device__ __forceinline__ void qkt(f32x16&p0,f32x16&p1,const char*Kslot,const bf16x8*qr,int r32,int hi){ const f32x16 negm=f32x16{};
  const char*kb=Kslot+hi*1024+r32*16;
  #pragma unroll
  for(int d0=0;d0<4;++d0){
    const bf16x8 b0=*reinterpret_cast<const bf16x8*>(kb+d0*2048);
    const bf16x8 b1=*reinterpret_cast<const bf16x8*>(kb+d0*2048+512);
    if(d0==0){p0=__builtin_amdgcn_mfma_f32_32x32x16_bf16(b0,qr[0],negm,0,0,0);p1=__builtin_amdgcn_mfma_f32_32x32x16_bf16(b1,qr[0],negm,0,0,0);}
    else{p0=__builtin_amdgcn_mfma_f32_32x32x16_bf16(b0,qr[d0],p0,0,0,0);p1=__builtin_amdgcn_mfma_f32_32x32x16_bf16(b1,qr[d0],p1,0,0,0);}}
}
typedef __attribute__((address_space(3))) const char* lds_cptr;
typedef short v4i16_t __attribute__((ext_vector_type(4)));
__device__ __forceinline__ void kload8(bf16x8*kf,lds_cptr kp){
  kf[0]=*(const __attribute__((address_space(3))) bf16x8*)(kp);      kf[1]=*(const __attribute__((address_space(3))) bf16x8*)(kp+512);
  kf[2]=*(const __attribute__((address_space(3))) bf16x8*)(kp+2048); kf[3]=*(const __attribute__((address_space(3))) bf16x8*)(kp+2560);
  kf[4]=*(const __attribute__((address_space(3))) bf16x8*)(kp+4096); kf[5]=*(const __attribute__((address_space(3))) bf16x8*)(kp+4608);
  kf[6]=*(const __attribute__((address_space(3))) bf16x8*)(kp+6144); kf[7]=*(const __attribute__((address_space(3))) bf16x8*)(kp+6656);
}
__device__ __forceinline__ void kload2(bf16x8*kf,lds_cptr kp,int j){ kf[2*j]=*(const __attribute__((address_space(3))) bf16x8*)(kp+j*2048); kf[2*j+1]=*(const __attribute__((address_space(3))) bf16x8*)(kp+j*2048+512); }
__device__ __forceinline__ s16x4 vtr(lds_cptr p){ return __builtin_bit_cast(s16x4,__builtin_amdgcn_ds_read_tr16_b64_v4i16((__attribute__((address_space(3))) v4i16_t*)p)); }
__device__ __forceinline__ float rowmax(const f32x16&p0,const f32x16&p1){
  float a=max3f(p0[0],p0[1],p1[0]),b=max3f(p0[2],p0[3],p1[1]);a=max3f(a,p1[2],p1[3]);
  #pragma unroll
  for(int r=4;r<16;r+=4){a=max3f(a,p0[r],p0[r+1]);b=max3f(b,p0[r+2],p0[r+3]);a=max3f(a,p1[r],p1[r+1]);b=max3f(b,p1[r+2],p1[r+3]);}
  const float m=max2f(a,b);
  auto rr=__builtin_amdgcn_permlane32_swap(__float_as_uint(m),__float_as_uint(m),false,false);
  return max2f(__uint_as_float(rr[0]),__uint_as_float(rr[1]));
}
__device__ __forceinline__ void pv(f32x16*o,int vb,bf16x8 pa0,bf16x8 pa1,bf16x8 pa2,bf16x8 pa3){
  #pragma unroll
  for(int d0=0;d0<2;++d0){s16x4 lo[4],hi[4];
    #pragma unroll
    for(int ks=0;ks<4;++ks){
      asm volatile("ds_read_b64_tr_b16 %0,%1 offset:%c2":"=&v"(lo[ks]):"v"(vb),"i"(d0*4096+ks*1024):"memory");
      asm volatile("ds_read_b64_tr_b16 %0,%1 offset:%c2":"=&v"(hi[ks]):"v"(vb),"i"(d0*4096+ks*1024+512):"memory");}
    asm volatile("s_waitcnt lgkmcnt(0)":::"memory");SBAR();
    #define PK(k) (bf16x8){lo[k][0],lo[k][1],lo[k][2],lo[k][3],hi[k][0],hi[k][1],hi[k][2],hi[k][3]}
    o[d0]=__builtin_amdgcn_mfma_f32_32x32x16_bf16(pa0,PK(0),o[d0],0,0,0);
    o[d0]=__builtin_amdgcn_mfma_f32_32x32x16_bf16(pa1,PK(1),o[d0],0,0,0);
    o[d0]=__builtin_amdgcn_mfma_f32_32x32x16_bf16(pa2,PK(2),o[d0],0,0,0);
    o[d0]=__builtin_amdgcn_mfma_f32_32x32x16_bf16(pa3,PK(3),o[d0],0,0,0);
    #undef PK
  }
}

#ifndef ATTN_STORE16
#define ATTN_STORE16(p,v) (*(u32x4*)(p)=(v))
#endif
template<int THRL> __device__ __forceinline__ void attn_unit(int b,int qb,const bf16*Q,const bf16*__restrict__ K,const bf16*__restrict__ V,bf16*O,char*shm){
  const int tid=threadIdx.x,lane=tid&63,r32=lane&31,hi=lane>>5; const int wid=__builtin_amdgcn_readfirstlane(tid>>6);
  const long rowbase=(long)b*SEQ; const int q0=qb*QB;
  const bf16*Qw=Q+(rowbase+q0+wid*QBLK)*PQ;
  const bf16*Kh=K+rowbase*PQ,*Vh=V+rowbase*PQ;
  const unsigned lds0=(unsigned)(uintptr_t)shm;
  float*wsf=(float*)(shm+LDS_WS)+wid*64;
  const bf16*ksrc=Kh+(long)lane*PQ+wid*8;
  const bf16*vsrc=Vh+(long)(16*(wid&3)+(lane>>2))*PQ+(wid>>2)*32+(lane&3)*8;
  const unsigned kdst=lds0+LDS_K+wid*1024, vdst=lds0+LDS_V+wid*1024;
  #define DMA_K(t,slot) glds16(ksrc+(long)(t)*KVBLK*PQ,(unsigned)__builtin_amdgcn_readfirstlane(kdst+(slot)))
  #define DMA_V(t,slot) glds16(vsrc+(long)(t)*KVBLK*PQ,(unsigned)__builtin_amdgcn_readfirstlane(vdst+(slot)))
  const int vb0=(int)(lds0+LDS_V)+((lane>>4)&1)*32+(lane&3)*8+(4*hi+((lane&15)>>2))*64;
  const char*Kbase=shm+LDS_K; bf16x8 kf[8];
  const lds_cptr shm3=(lds_cptr)shm; const lds_cptr kp0=shm3+LDS_K+hi*1024+r32*16; const lds_cptr vp0=shm3+LDS_V+((lane>>4)&1)*32+(lane&3)*8+(4*hi+((lane&15)>>2))*64;
  const int NT=(q0+QB)/KVBLK;
  DMA_K(0,0);DMA_V(0,0);DMA_K(1,SLOTB);
  bf16x8 qr[4];
  #pragma unroll
  for(int d0=0;d0<4;++d0)qr[d0]=*reinterpret_cast<const bf16x8*>(&Qw[(long)r32*PQ+d0*16+hi*8]);
  float mhat=0.f,l_reg=0.f;f32x16 o[2];o[0]=f32x16{};o[1]=f32x16{};
  const int qrel=wid*QBLK+r32;
  #define CMASK(P0,P1,t) do{int jb_=(t)-(NT-4); if(jb_>=0)cmask(P0,P1,jb_,qrel,hi);}while(0)
  bool resc=false;
  #define START(P0,P1) do{ const float rm=rowmax(P0,P1); resc=false; \
    { const float dl=rm; mhat=fadd_s(mhat,dl); \
      _Pragma("unroll") for(int r=0;r<16;++r){P0[r]=fsub_s(P0[r],dl);P1[r]=fsub_s(P1[r],dl);} \
      } \
    _Pragma("unroll") for(int r=0;r<16;++r)P0[r]=__builtin_amdgcn_exp2f(P0[r]); }while(0)
  #define RESC() do{ if(resc){ asm volatile("s_waitcnt lgkmcnt(0)":::"memory"); \
      _Pragma("unroll") for(int d_=0;d_<2;++d_) _Pragma("unroll") for(int r=0;r<16;++r)o[d_][r]*=wsf[crow(r,hi)]; } }while(0)
  f32x16 pA0,pA1,pB0,pB1;
  int sl_prev=0,sl_cur=0,sl_next=SLOTB;
  #define ROT() do{sl_prev=sl_cur;sl_cur=sl_next;sl_next=(sl_next==(NSLOT-1)*SLOTB)?0:sl_next+SLOTB;}while(0)
  DMA_K(2,2*SLOTB);
  WAIT_BAR(3);
  qkt(pA0,pA1,Kbase,qr,r32,hi);asm volatile("s_nop 15\n\ts_nop 7":"+v"(pA0),"+v"(pA1));CMASK(pA0,pA1,0);
  START(pA0,pA1);
  _Pragma("unroll") for(int r=0;r<16;++r)pA1[r]=__builtin_amdgcn_exp2f(pA1[r]);
  WAIT_BAR(0);
  DMA_K(3,0);DMA_V(1,SLOTB);
  ROT();
  kload8(kf,kp0+sl_cur);
  WAIT_BAR(2);
  s16x4 vlo[8],vhi[8]; u32x4 pw0,pw1,pw2,pw3;
  #define PKW(P,B) cvtpk_s(P[B],P[B+1])
  #define PAF(k) __builtin_bit_cast(bf16x8,pw##k)
  #define VFR(i) (bf16x8){vlo[i][0],vlo[i][1],vlo[i][2],vlo[i][3],vhi[i][0],vhi[i][1],vhi[i][2],vhi[i][3]}
  #define PIN(x) asm volatile("":"+v"(x))
  #define MX3(a,b,c) __builtin_fmaxf(__builtin_fmaxf((a),(b)),(c))
  #define GAPA(MF,A0,A1,A2,A3,W0,W1,PW) do{ MF; sacc+=A0; sacc+=A1; sacc+=A2; sacc+=A3; PIN(sacc); W0; W1; PIN(PW); SBAR(); }while(0)
  #define EX(v) __builtin_amdgcn_exp2f(v)
  #define GAPB(MF,X,B) do{ MF; X[B]=EX(X[B]-mhat); X[B+1]=EX(X[B+1]-mhat); X[B+2]=EX(X[B+2]-mhat); X[B+3]=EX(X[B+3]-mhat); PIN(X); SBAR(); }while(0)
  #define VRD(i) do{ vlo[i]=vtr(vp_+(((i)>>2)*4096+((i)&3)*1024)); vhi[i]=vtr(vp_+(((i)>>2)*4096+((i)&3)*1024+512)); }while(0)
  #define KRD(G,j) do{ if(G){ kload2(kf,kp0+sl_next,j); SBAR(); } }while(0)
  #define STEP(C0,C1,P0,P1,t,GK,GV,GL) do{ SBAR(); \
    const lds_cptr vp_=vp0+sl_prev; \
    VRD(0); SBAR(); float sacc=(P0[0]+P0[1]); \
    GAPA(C0=__builtin_amdgcn_mfma_f32_32x32x16_bf16(kf[0],qr[0],f32x16{},0,0,0), P0[2],P0[3],P0[4],P0[5],     pw0[0]=PKW(P0,0), pw0[1]=PKW(P0,2), pw0); \
    VRD(4); SBAR(); GAPA(C1=__builtin_amdgcn_mfma_f32_32x32x16_bf16(kf[1],qr[0],f32x16{},0,0,0), P0[6],P0[7],P0[8],P0[9],     pw0[2]=PKW(P0,4), pw0[3]=PKW(P0,6), pw0); \
    VRD(1); SBAR(); GAPA(C0=__builtin_amdgcn_mfma_f32_32x32x16_bf16(kf[2],qr[1],C0,0,0,0),   P0[10],P0[11],P0[12],P0[13], pw1[0]=PKW(P0,8), pw1[1]=PKW(P0,10), pw1); \
    VRD(5); SBAR(); GAPA(C1=__builtin_amdgcn_mfma_f32_32x32x16_bf16(kf[3],qr[1],C1,0,0,0),   P0[14],P0[15],P1[0],P1[1],   pw1[2]=PKW(P0,12),pw1[3]=PKW(P0,14), pw1); \
    VRD(2); SBAR(); GAPA(C0=__builtin_amdgcn_mfma_f32_32x32x16_bf16(kf[4],qr[2],C0,0,0,0),   P1[2],P1[3],P1[4],P1[5],     pw2[0]=PKW(P1,0), pw2[1]=PKW(P1,2), pw2); \
    VRD(6); SBAR(); GAPA(C1=__builtin_amdgcn_mfma_f32_32x32x16_bf16(kf[5],qr[2],C1,0,0,0),   P1[6],P1[7],P1[8],P1[9],     pw2[2]=PKW(P1,4), pw2[3]=PKW(P1,6), pw2); \
    VRD(3); SBAR(); GAPA(C0=__builtin_amdgcn_mfma_f32_32x32x16_bf16(kf[6],qr[3],C0,0,0,0),   P1[10],P1[11],P1[12],P1[13], pw3[0]=PKW(P1,8), pw3[1]=PKW(P1,10), pw3); \
    VRD(7); SBAR(); GAPA(C1=__builtin_amdgcn_mfma_f32_32x32x16_bf16(kf[7],qr[3],C1,0,0,0),   P1[14],P1[15],0.f,0.f,       pw3[2]=PKW(P1,12),pw3[3]=PKW(P1,14), pw3); \
    l_reg+=sacc; \
    if(GK){DMA_K((t)+3,sl_cur);} if(GV){DMA_V((t)+1,sl_next);} \
    CMASK(C0,C1,t); \
    { float a=MX3(C0[0],C0[1],C1[0]),b=MX3(C0[2],C0[3],C1[1]); a=MX3(a,C1[2],C1[3]); \
      _Pragma("unroll") for(int r=4;r<16;r+=4){a=MX3(a,C0[r],C0[r+1]);b=MX3(b,C0[r+2],C0[r+3]);a=MX3(a,C1[r],C1[r+1]);b=MX3(b,C1[r+2],C1[r+3]);} \
      float rm=__builtin_fmaxf(a,b); { auto rr=__builtin_amdgcn_permlane32_swap(__float_as_uint(rm),__float_as_uint(rm),false,false); rm=__builtin_fmaxf(__uint_as_float(rr[0]),__uint_as_float(rr[1])); } \
      resc=false; rm-=mhat; \
      if(__builtin_expect(__any(rm>(float)THRL),0)){ const float dl=__builtin_fmaxf(rm,0.f); mhat+=dl; \
        const float f=__builtin_amdgcn_exp2f(-dl); l_reg*=f; if(hi==0)wsf[r32]=f; resc=true; } } \
    SBAR(); \
    GAPB(o[0]=__builtin_amdgcn_mfma_f32_32x32x16_bf16(PAF(0),VFR(0),o[0],0,0,0), C0,0); \
    GAPB(o[1]=__builtin_amdgcn_mfma_f32_32x32x16_bf16(PAF(0),VFR(4),o[1],0,0,0), C0,4); \
    KRD(GL,0); GAPB(o[0]=__builtin_amdgcn_mfma_f32_32x32x16_bf16(PAF(1),VFR(1),o[0],0,0,0), C0,8); \
    KRD(GL,1); GAPB(o[1]=__builtin_amdgcn_mfma_f32_32x32x16_bf16(PAF(1),VFR(5),o[1],0,0,0), C0,12); \
    KRD(GL,2); GAPB(o[0]=__builtin_amdgcn_mfma_f32_32x32x16_bf16(PAF(2),VFR(2),o[0],0,0,0), C1,0); \
    KRD(GL,3); GAPB(o[1]=__builtin_amdgcn_mfma_f32_32x32x16_bf16(PAF(2),VFR(6),o[1],0,0,0), C1,4); \
    GAPB(o[0]=__builtin_amdgcn_mfma_f32_32x32x16_bf16(PAF(3),VFR(3),o[0],0,0,0), C1,8); \
    GAPB(o[1]=__builtin_amdgcn_mfma_f32_32x32x16_bf16(PAF(3),VFR(7),o[1],0,0,0), C1,12); \
    }while(0)
  int t=1;
  #undef CMASK
  #define CMASK(P0,P1,t) do{}while(0)
  for(;t+5<NT;t+=2){
    STEP(pB0,pB1,pA0,pA1,t,true,true,true);     WAIT_BAR(2); RESC(); ROT();
    STEP(pA0,pA1,pB0,pB1,t+1,true,true,true);   WAIT_BAR(2); RESC(); ROT();
  }
  #undef CMASK
  #define CMASK(P0,P1,t) do{int jb_=(t)-(NT-4); if(jb_>=0)cmask(P0,P1,jb_,qrel,hi);}while(0)
  #define ENDW(tt) do{ if((tt)+3<NT){WAIT_BAR(2);} else if((tt)+2<NT){WAIT_BAR(1);} else {WAIT_BAR(0);} }while(0)
  for(;t+1<NT;t+=2){
    STEP(pB0,pB1,pA0,pA1,t,(t+3<NT),(t+1<NT),(t+1<NT));       ENDW(t);   RESC(); ROT();
    STEP(pA0,pA1,pB0,pB1,t+1,(t+4<NT),(t+2<NT),(t+2<NT));     ENDW(t+1); RESC(); ROT();
  }
  STEP(pB0,pB1,pA0,pA1,NT-1,false,false,false); RESC();
  { float sacc=pB0[0]+pB0[1]; _Pragma("unroll") for(int r=2;r<16;++r)sacc+=pB0[r]; _Pragma("unroll") for(int r=0;r<16;++r)sacc+=pB1[r]; l_reg+=sacc;
    pw0=(u32x4){PKW(pB0,0),PKW(pB0,2),PKW(pB0,4),PKW(pB0,6)};pw1=(u32x4){PKW(pB0,8),PKW(pB0,10),PKW(pB0,12),PKW(pB0,14)};pw2=(u32x4){PKW(pB1,0),PKW(pB1,2),PKW(pB1,4),PKW(pB1,6)};pw3=(u32x4){PKW(pB1,8),PKW(pB1,10),PKW(pB1,12),PKW(pB1,14)};
    SBAR(); pv(o,vb0+sl_cur,PAF(0),PAF(1),PAF(2),PAF(3)); }
  #undef PKW
  #undef PAF
  #undef VFR
  #undef PIN
  #undef MX3
  #undef GAPA
  #undef GAPB
  #undef EX
  #undef VRD
  #undef KRD
  #undef STEP
  #undef ENDW
  {auto rr=__builtin_amdgcn_permlane32_swap(__float_as_uint(l_reg),__float_as_uint(l_reg),false,false);l_reg=__uint_as_float(rr[0])+__uint_as_float(rr[1]);}
  if(hi==0)wsf[32+r32]=l_reg;asm volatile("s_waitcnt lgkmcnt(0)":::"memory");
  float rli[16];
  #pragma unroll
  for(int r=0;r<16;++r)rli[r]=__builtin_amdgcn_rcpf(wsf[32+crow(r,hi)]);
  bf16*Ow=O+(rowbase+q0+wid*QBLK)*PO;
  { bf16*stg=(bf16*)(shm+LDS_OST)+wid*2048;
    #pragma unroll
    for(int r=0;r<16;++r){const int orow=crow(r,hi);
      #pragma unroll
      for(int d0=0;d0<2;++d0)stg[orow*64+d0*32+r32]=__float2bfloat16(o[d0][r]*rli[r]);}
    asm volatile("s_waitcnt lgkmcnt(0)":::"memory");
    #pragma unroll
    for(int i=0;i<4;++i){const int row=i*8+(lane>>3),ch=lane&7; const u32x4 v=*(const u32x4*)(stg+row*64+ch*8); ATTN_STORE16(Ow+(long)row*PO+ch*8,v);} }
  asm volatile("s_waitcnt lgkmcnt(0)\n\ts_barrier":::"memory");
  #undef DMA_K
  #undef DMA_V
  #undef CMASK
  #undef START
  #undef RESC
  #undef ROT
}
constexpr int ATTN_LDS_BYTES=LDS_BYTES;
constexpr int A2_K=0, A2_V=NSLOT*8192, A2_WS=A2_V+NSLOT*16384, A2_ST=A2_WS+NW*64*4, A2_BYTES=A2_ST+NW*8192;
#define A2_WAITBAR(N) asm volatile("s_waitcnt vmcnt(" #N ") lgkmcnt(0)\n\ts_barrier":::"memory")
template<int THRL> __device__ __forceinline__ void attn_unit2(int b,int qb,const bf16*Q,const bf16*__restrict__ K,const bf16*__restrict__ V,bf16*O,char*shm,int mode,float lam,const float*__restrict__ subg){
  const int tid=threadIdx.x,lane=tid&63,r32=lane&31,hi=lane>>5; const int wid=__builtin_amdgcn_readfirstlane(tid>>6);
  const long rowbase=(long)b*SEQ; const int q0=qb*QB;
  const bf16*Qw=Q+(rowbase+q0+wid*QBLK)*PQ;
  const bf16*Kh=K+rowbase*PQ,*Vh=V+rowbase*PQ;
  const unsigned lds0=(unsigned)(uintptr_t)shm;
  float*wsf=(float*)(shm+A2_WS)+wid*64;
  const bf16*ksrc=Kh+(long)lane*PQ+wid*8;
  const bf16*vsrc=Vh+(long)(16*(wid&3)+(lane>>2))*PQ+(wid>>2)*32+(lane&3)*8;
  const unsigned kdst=lds0+A2_K+wid*1024, vdst=lds0+A2_V+wid*1024;
  #define A2_DMA(t,sl) do{ glds16(ksrc+(long)(t)*KVBLK*PQ,(unsigned)__builtin_amdgcn_readfirstlane(kdst+(sl)*8192)); \
      glds16(vsrc+(long)(t)*KVBLK*PQ,(unsigned)__builtin_amdgcn_readfirstlane(vdst+(sl)*16384)); glds16(vsrc+(long)(t)*KVBLK*PQ+64,(unsigned)__builtin_amdgcn_readfirstlane(vdst+(sl)*16384+8192)); }while(0)
  const lds_cptr shm3=(lds_cptr)shm;
  const lds_cptr kp0=shm3+A2_K+hi*1024+r32*16;
  const lds_cptr vp0=shm3+A2_V+((lane>>4)&1)*32+(lane&3)*8+(4*hi+((lane&15)>>2))*64;
  const int NT=(q0+QB)/KVBLK;
  bf16x8 qr[4];
  #pragma unroll
  for(int d0=0;d0<4;++d0)qr[d0]=*reinterpret_cast<const bf16x8*>(&Qw[(long)r32*PQ+d0*16+hi*8]);
  A2_DMA(0,0); A2_DMA(1,1);
  float mhat=0.f,l_reg=0.f; f32x16 o[4]; o[0]=f32x16{}; o[1]=f32x16{}; o[2]=f32x16{}; o[3]=f32x16{};
  bool first=true; int sl=0;
  const int qw0=q0+wid*QBLK;
  for(int t=0;t<NT;++t){
    if(t+1<NT){A2_WAITBAR(3);}else{A2_WAITBAR(0);}
    if(t+2<NT){ const int s2=(sl==0)?2:sl-1; A2_DMA(t+2,s2); }
    {
      const int kv0=64*t;
      const bool two=!(kv0+32>qw0+31);
      f32x16 S0=f32x16{},S1=f32x16{};
      #pragma unroll
      for(int d0=0;d0<4;++d0){ const bf16x8 kf=*(const __attribute__((address_space(3))) bf16x8*)(kp0+sl*8192+d0*2048); S0=__builtin_amdgcn_mfma_f32_32x32x16_bf16(kf,qr[d0],S0,0,0,0); }
      if(two){
        #pragma unroll
        for(int d0=0;d0<4;++d0){ const bf16x8 kf=*(const __attribute__((address_space(3))) bf16x8*)(kp0+sl*8192+d0*2048+512); S1=__builtin_amdgcn_mfma_f32_32x32x16_bf16(kf,qr[d0],S1,0,0,0); } }
      if(kv0+63>qw0){ const int qpos=qw0+r32;
        #pragma unroll
        for(int r=0;r<16;++r){ const int kv=kv0+crow(r,hi); if(kv>qpos)S0[r]=-INFINITY; if(kv+32>qpos)S1[r]=-INFINITY; } }
      float rm=S0[0];
      #pragma unroll
      for(int r=1;r<16;++r)rm=__builtin_fmaxf(rm,S0[r]);
      if(two){
        #pragma unroll
        for(int r=0;r<16;++r)rm=__builtin_fmaxf(rm,S1[r]); }
      { auto rr=__builtin_amdgcn_permlane32_swap(__float_as_uint(rm),__float_as_uint(rm),false,false); rm=__builtin_fmaxf(__uint_as_float(rr[0]),__uint_as_float(rr[1])); }
      if(first){ mhat=rm; first=false; }
      else if(__any(rm-mhat>(float)THRL)){ const float dl=__builtin_fmaxf(rm-mhat,0.f); mhat+=dl; const float f=__builtin_amdgcn_exp2f(-dl); l_reg*=f;
        if(hi==0)wsf[r32]=f; asm volatile("s_waitcnt lgkmcnt(0)":::"memory");
        #pragma unroll
        for(int r=0;r<16;++r){ const float fr_=wsf[crow(r,hi)]; o[0][r]*=fr_; o[1][r]*=fr_; o[2][r]*=fr_; o[3][r]*=fr_; }
        asm volatile("s_waitcnt lgkmcnt(0)":::"memory"); }
      float ps=0.f;
      #pragma unroll
      for(int r=0;r<16;++r){ S0[r]=__builtin_amdgcn_exp2f(S0[r]-mhat); ps+=S0[r]; }
      u32x4 pw0,pw1,pw2,pw3;
      pw0=(u32x4){cvtpk_s(S0[0],S0[1]),cvtpk_s(S0[2],S0[3]),cvtpk_s(S0[4],S0[5]),cvtpk_s(S0[6],S0[7])};
      pw1=(u32x4){cvtpk_s(S0[8],S0[9]),cvtpk_s(S0[10],S0[11]),cvtpk_s(S0[12],S0[13]),cvtpk_s(S0[14],S0[15])};
      const lds_cptr vp=vp0+sl*16384;
      if(two){
        #pragma unroll
        for(int r=0;r<16;++r){ S1[r]=__builtin_amdgcn_exp2f(S1[r]-mhat); ps+=S1[r]; }
        pw2=(u32x4){cvtpk_s(S1[0],S1[1]),cvtpk_s(S1[2],S1[3]),cvtpk_s(S1[4],S1[5]),cvtpk_s(S1[6],S1[7])};
        pw3=(u32x4){cvtpk_s(S1[8],S1[9]),cvtpk_s(S1[10],S1[11]),cvtpk_s(S1[12],S1[13]),cvtpk_s(S1[14],S1[15])};
      }
      l_reg+=ps;
      __builtin_amdgcn_s_setprio(1);
      #pragma unroll
      for(int d0=0;d0<4;++d0){
        const s16x4 l0=vtr(vp+d0*4096), h0=vtr(vp+d0*4096+512), l1=vtr(vp+d0*4096+1024), h1=vtr(vp+d0*4096+1536);
        o[d0]=__builtin_amdgcn_mfma_f32_32x32x16_bf16(__builtin_bit_cast(bf16x8,pw0),(bf16x8){l0[0],l0[1],l0[2],l0[3],h0[0],h0[1],h0[2],h0[3]},o[d0],0,0,0);
        o[d0]=__builtin_amdgcn_mfma_f32_32x32x16_bf16(__builtin_bit_cast(bf16x8,pw1),(bf16x8){l1[0],l1[1],l1[2],l1[3],h1[0],h1[1],h1[2],h1[3]},o[d0],0,0,0);
      }
      if(two){
        #pragma unroll
        for(int d0=0;d0<4;++d0){
          const s16x4 l0=vtr(vp+d0*4096+2048), h0=vtr(vp+d0*4096+2560), l1=vtr(vp+d0*4096+3072), h1=vtr(vp+d0*4096+3584);
          o[d0]=__builtin_amdgcn_mfma_f32_32x32x16_bf16(__builtin_bit_cast(bf16x8,pw2),(bf16x8){l0[0],l0[1],l0[2],l0[3],h0[0],h0[1],h0[2],h0[3]},o[d0],0,0,0);
          o[d0]=__builtin_amdgcn_mfma_f32_32x32x16_bf16(__builtin_bit_cast(bf16x8,pw3),(bf16x8){l1[0],l1[1],l1[2],l1[3],h1[0],h1[1],h1[2],h1[3]},o[d0],0,0,0);
        }
      }
      __builtin_amdgcn_s_setprio(0);
    }
    sl=(sl==NSLOT-1)?0:sl+1;
  }
  {auto rr=__builtin_amdgcn_permlane32_swap(__float_as_uint(l_reg),__float_as_uint(l_reg),false,false);l_reg=__uint_as_float(rr[0])+__uint_as_float(rr[1]);}
  if(hi==0)wsf[32+r32]=l_reg; asm volatile("s_waitcnt lgkmcnt(0)":::"memory");
  float rli[16];
  #pragma unroll
  for(int r=0;r<16;++r)rli[r]=__builtin_amdgcn_rcpf(wsf[32+crow(r,hi)]);
  char*st=shm+A2_ST+wid*8192;
  if(mode==0){
    #pragma unroll
    for(int k=0;k<8;++k){ const int d0=k>>1,r0=8*(k&1);
      const u32x4 w={cvtpk_s(o[d0][r0]*rli[r0],o[d0][r0+1]*rli[r0+1]),cvtpk_s(o[d0][r0+2]*rli[r0+2],o[d0][r0+3]*rli[r0+3]),cvtpk_s(o[d0][r0+4]*rli[r0+4],o[d0][r0+5]*rli[r0+5]),cvtpk_s(o[d0][r0+6]*rli[r0+6],o[d0][r0+7]*rli[r0+7])};
      *(u32x4*)(st+k*1024+lane*16)=w; }
  }else{
    const float nl=-lam;
    #pragma unroll
    for(int k=0;k<8;++k){ const int d0=k>>1,r0=8*(k&1); const u32x4 c=*(const u32x4*)(st+k*1024+lane*16);
      #pragma unroll
      for(int j=0;j<4;++j){ const unsigned u=c[j]; const unsigned ulo=u<<16,uhi=u&0xffff0000u;
        o[d0][r0+2*j]=__builtin_fmaf(nl,o[d0][r0+2*j]*rli[r0+2*j],__uint_as_float(ulo));
        o[d0][r0+2*j+1]=__builtin_fmaf(nl,o[d0][r0+2*j+1]*rli[r0+2*j+1],__uint_as_float(uhi)); } }
    asm volatile("s_waitcnt lgkmcnt(0)":::"memory");
    const float g0_=subg[r32],g1_=subg[32+r32],g2_=subg[64+r32],g3_=subg[96+r32];
    bf16*stg=(bf16*)st; bf16*Ow=O+(rowbase+q0+wid*QBLK)*PO;
    #pragma unroll
    for(int r=0;r<16;++r){ float ss=(o[0][r]*o[0][r]+o[1][r]*o[1][r])+(o[2][r]*o[2][r]+o[3][r]*o[3][r]);
      ss+=__shfl_xor(ss,1); ss+=__shfl_xor(ss,2); ss+=__shfl_xor(ss,4); ss+=__shfl_xor(ss,8); ss+=__shfl_xor(ss,16);
      const float rs=0.8f/sqrtf(ss*(1.0f/128.0f)+1e-5f); const int orow=crow(r,hi);
      stg[orow*128+r32]=__float2bfloat16(o[0][r]*rs*g0_); stg[orow*128+32+r32]=__float2bfloat16(o[1][r]*rs*g1_); stg[orow*128+64+r32]=__float2bfloat16(o[2][r]*rs*g2_); stg[orow*128+96+r32]=__float2bfloat16(o[3][r]*rs*g3_); }
    asm volatile("s_waitcnt lgkmcnt(0)":::"memory");
    #pragma unroll
    for(int i=0;i<8;++i){ const int row=i*4+(lane>>4),ch=lane&15; const u32x4 v=*(const u32x4*)(stg+row*128+ch*8); ATTN_STORE16(Ow+(long)row*PO+ch*8,v); }
  }
  asm volatile("s_waitcnt lgkmcnt(0)\n\ts_barrier":::"memory");
  #undef A2_DMA
}
#undef A2_WAITBAR
struct AttnTensors { const bf16* Q; const bf16* K; const bf16* V; bf16* O; float lam; const float* subg; };
struct AttnUnit { int b, hm, vh, qb; };
struct StaticOrder {
  int vcu, G;
  __device__ __forceinline__ explicit StaticOrder(int grid,int v):vcu(v),G(grid){}
  __device__ __forceinline__ bool next(int i,AttnUnit&u)const{ const int vv=vcu+(i>>3)*G; if(vv>=256)return false; const int bh=vv>>3,p=vv&7,j=i&7,combo=j&3;
    u.b=bh>>2; u.hm=2*(bh&3)+(combo>>1); u.vh=combo&1; u.qb=(j<4)?15-p:p; return true; }
  __device__ __forceinline__ void a_ready(const AttnUnit&)const{}
  __device__ __forceinline__ void done(const AttnUnit&)const{}
};
template<class Sched,int THRL=8> __device__ __forceinline__ void attn_phase(char*lds,const AttnTensors&T,const Sched&S){
  AttnUnit u;
  for(int i=0;S.next(i,u);++i){ S.a_ready(u);
    attn_unit<THRL>(u.b,u.qb,T.Q+u.hm*64,T.K+u.hm*64,T.V+(u.hm>>1)*128+u.vh*64,T.O+u.hm*128+u.vh*64,lds); S.done(u); }
}
struct StaticOrder2 {
  int vcu, G;
  __device__ __forceinline__ explicit StaticOrder2(int grid,int v):vcu(v),G(grid){}
  __device__ __forceinline__ bool next(int i,AttnUnit&u)const{ const int vv=vcu+(i>>2)*G; if(vv>=256)return false; const int bh=vv>>3,p=vv&7,j=i&3;
    u.b=bh>>2; u.hm=2*(bh&3)+(j&1); u.vh=0; u.qb=(j<2)?15-p:p; return true; }
};
template<class Sched,int THRL=8> __device__ __forceinline__ void attn_phase2(char*lds,const AttnTensors&T,const Sched&S){
  AttnUnit u;
  for(int i=0;S.next(i,u);++i){ attn_unit2<THRL>(u.b,u.qb,T.Q+u.hm*64,T.K+u.hm*64,T.V+(u.hm>>1)*128,T.O+(u.hm>>1)*128,lds,u.hm&1,T.lam,T.subg); }
}
#undef SBAR
#undef WAIT_BAR
}
#define GAS __attribute__((address_space(1)))
#define LAS __attribute__((address_space(3)))
typedef unsigned short bf16;
typedef unsigned v4u __attribute__((ext_vector_type(4)));
typedef float f32x4 __attribute__((ext_vector_type(4)));
typedef short bf16x8 __attribute__((ext_vector_type(8)));
typedef GAS unsigned gu32;
typedef GAS unsigned long long gu64;
#define RLX_AGENT __ATOMIC_RELAXED, __HIP_MEMORY_SCOPE_AGENT
#define LDS_WAIT() asm volatile("s_waitcnt lgkmcnt(0)" ::: "memory")
#define VM_WAIT() asm volatile("s_waitcnt vmcnt(0)" ::: "memory")
__device__ __forceinline__ unsigned long long rt() { return __builtin_amdgcn_s_memrealtime(); }
__device__ __forceinline__ unsigned f2bf(float f) { unsigned u = __builtin_bit_cast(unsigned, f); return (u + 0x7fffu + ((u >> 16) & 1u)) >> 16; }
__device__ __forceinline__ unsigned pk2(float lo, float hi) { return f2bf(lo) | (f2bf(hi) << 16); }

#define XB_TMO      128
#define XB_XCNT(j)  (256  + 64 * (j))
#define XB_XSUB(j)  (1280 + 64 * (j))
#define XB_XGEN(j)  (2304 + 64 * (j))
#define XB_TOP      3328
#define XB_TOPGEN   3392
#define XCD_BAR_WORDS 3456
#define XB_SPIN_CAP (1u << 22)

__device__ __forceinline__ unsigned xb_ld(unsigned* p)              { return __hip_atomic_load(p, __ATOMIC_RELAXED, __HIP_MEMORY_SCOPE_AGENT); }
__device__ __forceinline__ unsigned xb_add(unsigned* p, unsigned v) { return __hip_atomic_fetch_add(p, v, __ATOMIC_RELAXED, __HIP_MEMORY_SCOPE_AGENT); }
__device__ __forceinline__ unsigned xb_xcc_id() { return (unsigned)__builtin_amdgcn_s_getreg((3 << 11) | 20) & 0xFu; }
#define XB_SPIN(cond, bar) do { unsigned _sp = 0; while (cond) { __builtin_amdgcn_s_sleep(1); \
    if ((++_sp & 255u) == 0u) { if (xb_ld(&(bar)[XB_TMO])) break; if (_sp > XB_SPIN_CAP) { atomicAdd(&(bar)[XB_TMO], 1u); break; } } } } while (0)

struct XcdBarrier {
    unsigned* bar; unsigned x;
    volatile LAS unsigned* st;
};

__device__ __forceinline__ XcdBarrier xcd_barrier_post(unsigned* bar, volatile LAS unsigned* st) {
    XcdBarrier b; b.bar = bar; b.x = xb_xcc_id(); b.st = st;
    if (threadIdx.x == 0) (void)xb_add(&bar[XB_XCNT(b.x)], 1u);
    return b;
}
__device__ __forceinline__ void xcd_barrier_complete(unsigned* bar, unsigned x, unsigned& nloc, unsigned& nx) {
    const unsigned G = gridDim.x * gridDim.y * gridDim.z;
    unsigned sum, cnt, mine, sp = 0u;
    for (;;) {
        sum = 0u; cnt = 0u; mine = 0u;
#pragma unroll
        for (unsigned j = 0; j < 16; ++j) { const unsigned c = xb_ld(&bar[XB_XCNT(j)]); sum += c; cnt += (c > 0u) ? 1u : 0u; mine = (j == x) ? c : mine; }
        if (sum == G) break;
        __builtin_amdgcn_s_sleep(1);
        if ((++sp & 255u) == 0u) { if (xb_ld(&bar[XB_TMO])) break; if (sp > XB_SPIN_CAP) { atomicAdd(&bar[XB_TMO], 1u); break; } }
    }
    nloc = mine > 0u ? mine : 1u; nx = cnt > 0u ? cnt : 1u;
}

__device__ __forceinline__ void xcd_barrier(const XcdBarrier& b) {
    asm volatile("s_waitcnt vmcnt(0)" ::: "memory");
    __syncthreads();
    if (threadIdx.x == 0) {
        unsigned* bar = b.bar;
        __builtin_amdgcn_s_waitcnt(0);
        unsigned nloc = b.st[0], nx = b.st[1];
        if (nloc == 0u) { xcd_barrier_complete(bar, b.x, nloc, nx); b.st[0] = nloc; b.st[1] = nx; }
        const unsigned old = xb_add(&bar[XB_XSUB(b.x)], 1u);
        const unsigned gen = old / nloc;
        if (old + 1u == (gen + 1u) * nloc) {
            __builtin_amdgcn_fence(__ATOMIC_RELEASE, "agent");
            asm volatile("s_waitcnt vmcnt(0)" ::: "memory");
            const unsigned og = xb_add(&bar[XB_TOP], 1u);
            const unsigned tg = og / nx;
            if (og + 1u == (tg + 1u) * nx) xb_add(&bar[XB_TOPGEN], 1u);
            else XB_SPIN(xb_ld(&bar[XB_TOPGEN]) == tg, bar);
            __builtin_amdgcn_fence(__ATOMIC_ACQUIRE, "agent");
            xb_add(&bar[XB_XGEN(b.x)], 1u);
            asm volatile("s_waitcnt vmcnt(0)" ::: "memory");
        } else {
            XB_SPIN(xb_ld(&bar[XB_XGEN(b.x)]) == gen, bar);
            __builtin_amdgcn_fence(__ATOMIC_ACQUIRE, "agent");
            asm volatile("s_waitcnt vmcnt(0)" ::: "memory");
        }
    }
    __syncthreads();
}

constexpr int NWAVES = 8;
constexpr int NTOK = 32768, SEQL = 4096, DMODEL = 1024, INW = 2560, FFND = 2816, NEXP = 8, EDIM = 3584;
constexpr int MAXTILES = 264;
constexpr size_t MiB = 1u << 20;
constexpr size_t WS_CTL = 510 * MiB, CTL_ZERO_BYTES = 2 * MiB;
constexpr size_t WS_WIN = 1 * MiB, WS_WOUT = 6 * MiB, WS_WF1 = 8 * MiB, WS_WF2 = 19 * MiB, WS_WPL = 25 * MiB;
constexpr size_t WS_WM1 = 26 * MiB, WS_WM2 = 82 * MiB;
constexpr size_t WS_TAB = 110 * MiB;
constexpr size_t WS_ROPE = WS_TAB, WS_SSQ1 = WS_TAB + 1 * MiB, WS_SSQ2 = WS_TAB + 3 * MiB, WS_TOPK = WS_TAB + 5 * MiB, WS_CNT = WS_TAB + 5 * MiB + 512 * 1024,
                 WS_STOK = WS_TAB + 6 * MiB, WS_SSLOT = WS_TAB + 6 * MiB + 512 * 1024, WS_SGATE = WS_TAB + 7 * MiB, WS_TINFO = WS_TAB + 7 * MiB + 512 * 1024;
constexpr size_t WS_RGW = WS_TAB + 512 * 1024;
constexpr size_t WS_SUMM = WS_CTL + 1 * MiB;
constexpr size_t WS_SLOTA = 118 * MiB;
constexpr size_t WS_XN = 406 * MiB;
constexpr size_t WS_PROJ = 182 * MiB;
constexpr size_t WS_AR = 342 * MiB;
constexpr size_t WS_XS = WS_TAB + 7 * MiB + 640 * 1024;
constexpr size_t WS_H1B = 150 * MiB;
constexpr size_t WS_HID = 246 * MiB;
constexpr size_t WS_H1Q = 334 * MiB;
constexpr size_t WS_Y = 214 * MiB;
constexpr size_t WS_HIDS = 278 * MiB;
constexpr size_t WS_END = 512 * MiB;
static_assert(WS_HID + (size_t)NTOK * FFND * 2 <= WS_END && WS_HIDS + (size_t)MAXTILES * 256 * EDIM <= WS_CTL && WS_CTL + CTL_ZERO_BYTES <= WS_END && WS_AR + (size_t)NTOK * 1024 * 2 <= WS_END && WS_Y + (size_t)2 * NTOK * 1024 <= WS_HIDS && WS_H1B + (size_t)NTOK * 1024 * 2 <= WS_Y && WS_SLOTA + (size_t)NTOK * 1024 <= WS_H1B && WS_XN + (size_t)NTOK * 1024 * 2 <= WS_END, "d_ws map");
static_assert(WS_WM1 + (size_t)NEXP * 7168 * 1024 <= WS_WM2 && WS_WM2 + (size_t)NEXP * 1024 * EDIM <= WS_TAB, "d_ws weights map");
constexpr int CW_TMO = 0, CW_CODE = 1, CW_BAR = 4096, CW_RGF = 65536;
constexpr int RING_OFF = 0, RING_BYTES = 131072;
constexpr int LDSCTL_OFF = 141312, MISC_OFF = LDSCTL_OFF + 320;
static_assert(LDSCTL_OFF >= RING_BYTES && LDSCTL_OFF >= attn_body::A2_BYTES, "LDS map");
constexpr int LDS_BYTES = 147456;
static_assert(MISC_OFF + 128 <= LDS_BYTES, "LDS map");

__device__ __forceinline__ float wave_sum(float v) {
#pragma unroll
    for (int o = 1; o < 64; o <<= 1) v += __shfl_xor(v, o);
    return v;
}
__device__ __forceinline__ float bf2f(bf16 v) { return __builtin_bit_cast(float, (unsigned)v << 16); }
__device__ __forceinline__ float sigmoidf_(float x) { return 1.0f / (1.0f + __expf(-x)); }
__device__ __forceinline__ float gelu_tanh(float x) { const float z = 0.7978845608028654f * (x + 0.044715f * x * x * x); const float t = 1.0f - 2.0f / (1.0f + __expf(2.0f * z)); return 0.5f * x * (1.0f + t); }

__device__ __forceinline__ void tr_item(const float* W, int N, int k0, int n0, const float* gain, bf16* WT, size_t drow0, int ldk, LAS float* scr, int lane) {
    float v[32];
    const float* wp = W + (size_t)(k0 + (lane >> 5)) * N + n0 + (lane & 31);
#pragma unroll
    for (int i = 0; i < 32; ++i) v[i] = wp[(size_t)(2 * i) * N];
    const int c = lane & 7;
    f32x4 g0 = (f32x4){1.f, 1.f, 1.f, 1.f}, g1 = g0;
    if (gain) { g0 = *(const f32x4*)(gain + k0 + 8 * c); g1 = *(const f32x4*)(gain + k0 + 8 * c + 4); }
#pragma unroll
    for (int i = 0; i < 32; ++i) scr[(2 * i + (lane >> 5)) * 33 + (lane & 31)] = v[i];
    LDS_WAIT(); asm volatile("" ::: "memory");
#pragma unroll
    for (int j = 0; j < 4; ++j) { const int n = (lane >> 3) + 8 * j; const LAS float* s = scr + (8 * c) * 33 + n;
        v4u o; o.x = pk2(s[0 * 33] * g0.x, s[1 * 33] * g0.y); o.y = pk2(s[2 * 33] * g0.z, s[3 * 33] * g0.w); o.z = pk2(s[4 * 33] * g1.x, s[5 * 33] * g1.y); o.w = pk2(s[6 * 33] * g1.z, s[7 * 33] * g1.w);
        *(GAS v4u*)(WT + (drow0 + n) * (size_t)ldk + k0 + 8 * c) = o; }
    LDS_WAIT(); asm volatile("" ::: "memory");
}

__device__ __forceinline__ void tr_item8(const float* W, int N, int k0, int n0, const float* gain, float sc, unsigned char* WT, size_t drow0, int ldk, LAS float* scr, int lane) {
    float v[32];
    const float* wp = W + (size_t)(k0 + (lane >> 5)) * N + n0 + (lane & 31);
#pragma unroll
    for (int i = 0; i < 32; ++i) v[i] = wp[(size_t)(2 * i) * N];
    const int c = lane & 7;
    f32x4 g0 = (f32x4){sc, sc, sc, sc}, g1 = g0;
    if (gain) { g0 = *(const f32x4*)(gain + k0 + 8 * c) * sc; g1 = *(const f32x4*)(gain + k0 + 8 * c + 4) * sc; }
#pragma unroll
    for (int i = 0; i < 32; ++i) scr[(2 * i + (lane >> 5)) * 33 + (lane & 31)] = v[i];
    LDS_WAIT(); asm volatile("" ::: "memory");
#pragma unroll
    for (int j = 0; j < 4; ++j) { const int n = (lane >> 3) + 8 * j; const LAS float* s = scr + (8 * c) * 33 + n;
        pg8::u32x2 o; o.x = pg8::cvt4_fp8(s[0 * 33] * g0.x, s[1 * 33] * g0.y, s[2 * 33] * g0.z, s[3 * 33] * g0.w); o.y = pg8::cvt4_fp8(s[4 * 33] * g1.x, s[5 * 33] * g1.y, s[6 * 33] * g1.z, s[7 * 33] * g1.w);
        *(GAS pg8::u32x2*)(WT + (drow0 + n) * (size_t)ldk + k0 + 8 * c) = o; }
    LDS_WAIT(); asm volatile("" ::: "memory");
}

#ifndef MK_REP
#define MK_REP -1
#endif
struct Args { const float* in[29]; float* out; unsigned char* ws; int ph_lo, ph_hi; };
constexpr int PH_FINAL = 13, PH_END = 14;

__global__ void __launch_bounds__(NWAVES * 64, 2) mk_fwd(Args args) {
    extern __shared__ __attribute__((aligned(16))) unsigned char lds_raw[];
    LAS unsigned char* lds = (LAS unsigned char*)lds_raw;
    volatile LAS unsigned* MISC = (volatile LAS unsigned*)(lds + MISC_OFF);
    const int G = gridDim.x, bid = blockIdx.x;
    const int vcu = (G % 8 == 0) ? (bid % 8) * (G / 8) + bid / 8 : bid;
    typedef const __attribute__((address_space(4))) char* kargp_t;
#define KARG(kp) kargp_t kp = (kargp_t)__builtin_amdgcn_kernarg_segment_ptr(); asm volatile("" : "+s"(kp))
#define KIN(kp, k) (*(const float* const __attribute__((address_space(4)))*)((kp) + 8 * (k)))
#define KOUT(kp) (*(float* const __attribute__((address_space(4)))*)((kp) + 232))
#define KWS(kp) (*(unsigned char* const __attribute__((address_space(4)))*)((kp) + 240))
    gu32* ctl;
    { KARG(kp); ctl = (gu32*)(KWS(kp) + WS_CTL); }
    for (int u = threadIdx.x; u < (LDS_BYTES - LDSCTL_OFF) / 4; u += NWAVES * 64) ((LAS unsigned*)(lds + LDSCTL_OFF))[u] = 0u;
    __syncthreads();
    const int lo = args.ph_lo, hi = args.ph_hi;
    const bool multi = (hi - lo) > 1;
    XcdBarrier bar; bar.bar = (unsigned*)(ctl + CW_BAR); bar.x = 0; bar.st = nullptr;
    if (multi) bar = xcd_barrier_post((unsigned*)(ctl + CW_BAR), MISC + 8);
#ifndef PHMASK
#define PHMASK 0xffffffffu
#endif
#define IN(k) (((PHMASK >> (k)) & 1u) && lo <= (k) && (k) < hi)
#define BOTH(k) (IN(k) && IN((k) == 2 ? 4 : (k) + 1))
#define GRID_BAR() xcd_barrier(bar)
#define PHASE_IDS() int tid_ = threadIdx.x; asm volatile("" : "+v"(tid_)); const int tid = tid_, lane = tid & 63, wave = __builtin_amdgcn_readfirstlane(tid >> 6), gw = vcu * NWAVES + wave, NGW = G * NWAVES; (void)lane; (void)gw; (void)NGW

    if (IN(0)) for (int rep_ = 0; rep_ < 1 + (MK_REP == 0 ? 1 : 0); ++rep_) {
        PHASE_IDS(); KARG(kp); unsigned char* ws = KWS(kp);
        const float* x = KIN(kp, 0); const float* ln_mix_even = KIN(kp, 1); const float* w_in = KIN(kp, 2); const float* w_out = KIN(kp, 15); const float* ln_ffn_even = KIN(kp, 16);
        const float* ffn_wg = KIN(kp, 17); const float* ffn_wu = KIN(kp, 18); const float* ffn_wd = KIN(kp, 19); const float* ln_mix_odd = KIN(kp, 20); const float* pool_w = KIN(kp, 21);
        const float* ln_ffn_odd = KIN(kp, 23); const float* moe_wg = KIN(kp, 25); const float* moe_wu = KIN(kp, 26); const float* moe_wd = KIN(kp, 27);
        bf16* WIN = (bf16*)(ws + WS_WIN); bf16* WOUT = (bf16*)(ws + WS_WOUT); bf16* WF1 = (bf16*)(ws + WS_WF1); bf16* WF2 = (bf16*)(ws + WS_WF2);
        bf16* WPL = (bf16*)(ws + WS_WPL); unsigned char* WM1 = ws + WS_WM1; unsigned char* WM2 = ws + WS_WM2; float* ROPE = (float*)(ws + WS_ROPE); bf16* SLOTA = (bf16*)(ws + WS_XN);
        LAS float* scr = (LAS float*)(lds + RING_OFF + wave * 16384);
        constexpr int I_IN = 16 * 80, I_OUT = 16 * 32, I_F1 = 16 * 88, I_F2 = 44 * 32, I_PL = 4 * 32, I_M1 = 8 * 16 * 112, I_M2 = 8 * 56 * 32;
        constexpr int NITEMS = I_IN + I_OUT + 2 * I_F1 + I_F2 + I_PL + 2 * I_M1 + I_M2;
        struct TrD { const float* wp; const float* gain; unsigned char* dst; int N, ldk, fp8; float sc; };
        auto desc = [&](int it) -> TrD {
            TrD d; int r = it; d.sc = 1.f; d.fp8 = 0; d.gain = nullptr;
            const float* W; int N, k0, n0, ldk; size_t drow0; unsigned char* WT;
            if (r < I_IN) { const int kb = r / 80, nb = r % 80; W = w_in; N = INW; k0 = 64 * kb; n0 = 32 * nb; d.gain = ln_mix_even; WT = (unsigned char*)WIN; drow0 = 32 * nb; ldk = 1024; }
            else if ((r -= I_IN) < I_OUT) { const int kb = r / 32, nb = r % 32; W = w_out; N = 1024; k0 = 64 * kb; n0 = 32 * nb; WT = (unsigned char*)WOUT; drow0 = 32 * nb; ldk = 1024; }
            else if ((r -= I_OUT) < 2 * I_F1) { const int up = r >= I_F1 ? 1 : 0, rr = r - up * I_F1, kb = rr / 88, nb = rr % 88; W = up ? ffn_wu : ffn_wg; N = FFND; k0 = 64 * kb; n0 = 32 * nb; d.gain = ln_ffn_even; WT = (unsigned char*)WF1; drow0 = (size_t)(256 * (n0 / 128) + (n0 % 128) + up * 128); ldk = 1024; }
            else if ((r -= 2 * I_F1) < I_F2) { const int kb = r / 32, nb = r % 32; W = ffn_wd; N = 1024; k0 = 64 * kb; n0 = 32 * nb; d.fp8 = 1; d.sc = 64.0f; WT = (unsigned char*)WF2; drow0 = 32 * nb; ldk = FFND; }
            else if ((r -= I_F2) < I_PL) { const int g = r / 32, rr = r % 32, kb = rr / 8, nb = rr % 8; W = pool_w + (size_t)g * 65536; N = 256; k0 = 64 * kb; n0 = 32 * nb; d.gain = ln_mix_odd + 256 * g; WT = (unsigned char*)WPL; drow0 = (size_t)(256 * g + 32 * nb); ldk = 256; }
            else if ((r -= I_PL) < 2 * I_M1) { const int up = r >= I_M1 ? 1 : 0, rr = r - up * I_M1, e = rr / 1792, r2 = rr % 1792, kb = r2 / 112, nb = r2 % 112; W = (up ? moe_wu : moe_wg) + (size_t)e * 1024 * EDIM; N = EDIM; k0 = 64 * kb; n0 = 32 * nb;
                d.gain = ln_ffn_odd; d.sc = 32.0f; d.fp8 = 1; WT = WM1; drow0 = (size_t)e * 7168 + (size_t)(256 * (n0 / 128) + (n0 % 128) + up * 128); ldk = 1024; }
            else { r -= 2 * I_M1; const int e = r / 1792, r2 = r % 1792, kb = r2 / 32, nb = r2 % 32; W = moe_wd + (size_t)e * EDIM * 1024; N = 1024; k0 = 64 * kb; n0 = 32 * nb; d.sc = 64.0f; d.fp8 = 1; WT = WM2; drow0 = (size_t)e * 1024 + 32 * nb; ldk = EDIM; }
            d.wp = W + (size_t)(k0 + (lane >> 5)) * N + n0 + (lane & 31); d.N = N; d.ldk = ldk; if (d.gain) d.gain += k0;
            d.dst = WT + (drow0 * (size_t)ldk + k0) * (d.fp8 ? 1 : 2);
            return d; };
        {
            int it = gw; bool have = it < NITEMS; TrD d{}; float v[32];
            if (have) { d = desc(it);
#pragma unroll
                for (int i = 0; i < 32; ++i) v[i] = __builtin_nontemporal_load(d.wp + (size_t)(2 * i) * d.N); }
            while (have) {
                const int itn = it + NGW; const bool haven = itn < NITEMS; TrD dn{}; float vn[32];
                if (haven) { dn = desc(itn);
#pragma unroll
                    for (int i = 0; i < 32; ++i) vn[i] = __builtin_nontemporal_load(dn.wp + (size_t)(2 * i) * dn.N); }
                const int c = lane & 7;
                f32x4 g0 = (f32x4){d.sc, d.sc, d.sc, d.sc}, g1 = g0;
                if (d.gain) { g0 = *(const f32x4*)(d.gain + 8 * c) * d.sc; g1 = *(const f32x4*)(d.gain + 8 * c + 4) * d.sc; }
#pragma unroll
                for (int i = 0; i < 32; ++i) scr[(2 * i + (lane >> 5)) * 33 + (lane & 31)] = v[i];
                LDS_WAIT(); asm volatile("" ::: "memory");
#pragma unroll
                for (int j = 0; j < 4; ++j) { const int n = (lane >> 3) + 8 * j; const LAS float* s = scr + (8 * c) * 33 + n;
                    const float e0 = s[0 * 33] * g0.x, e1 = s[1 * 33] * g0.y, e2 = s[2 * 33] * g0.z, e3 = s[3 * 33] * g0.w, e4 = s[4 * 33] * g1.x, e5 = s[5 * 33] * g1.y, e6 = s[6 * 33] * g1.z, e7 = s[7 * 33] * g1.w;
                    if (d.fp8) { pg8::u32x2 o; o.x = pg8::cvt4_fp8(e0, e1, e2, e3); o.y = pg8::cvt4_fp8(e4, e5, e6, e7); *(GAS pg8::u32x2*)(d.dst + (size_t)n * d.ldk + 8 * c) = o; }
                    else { v4u o; o.x = pk2(e0, e1); o.y = pk2(e2, e3); o.z = pk2(e4, e5); o.w = pk2(e6, e7); *(GAS v4u*)(d.dst + ((size_t)n * d.ldk + 8 * c) * 2) = o; } }
                LDS_WAIT(); asm volatile("" ::: "memory");
#pragma unroll
                for (int i = 0; i < 32; ++i) v[i] = vn[i];
                d = dn; it = itn; have = haven;
            }
        }
        for (int e = bid * (NWAVES * 64) + tid; e < SEQL * 8; e += G * NWAVES * 64) {
            const int pos = e >> 3, i = e & 7;
            const float inv = (i == 0) ? 1.000000000e+00f : (i == 1) ? 1.939227432e-01f : (i == 2) ? 3.760603070e-02f : (i == 3) ? 7.292664610e-03f : (i == 4) ? 1.414213562e-03f : (i == 5) ? 2.742481884e-04f : (i == 6) ? 5.318295734e-05f : 1.031338525e-05f;
            const float angf = (float)pos * inv; const double a = (double)angf;
            const double q = __builtin_rint(a * 0.63661977236758134308); const double rr = (a - q * 1.57079632679489655800) - q * 6.123233995736766036e-17; const int qi = (int)q & 3;
            const double r2 = rr * rr;
            const double sn = rr * (1.0 + r2 * (-1.0 / 6 + r2 * (1.0 / 120 + r2 * (-1.0 / 5040 + r2 * (1.0 / 362880 + r2 * (-1.0 / 39916800 + r2 * (1.0 / 6227020800.0)))))));
            const double cn = 1.0 + r2 * (-0.5 + r2 * (1.0 / 24 + r2 * (-1.0 / 720 + r2 * (1.0 / 40320 + r2 * (-1.0 / 3628800 + r2 * (1.0 / 479001600 + r2 * (-1.0 / 87178291200.0)))))));
            const double c = (qi == 0) ? cn : (qi == 1) ? -sn : (qi == 2) ? -cn : sn, s = (qi == 0) ? sn : (qi == 1) ? cn : (qi == 2) ? -sn : -cn;
            ROPE[2 * e] = (float)c; ROPE[2 * e + 1] = (float)s;
        }
        { const float* rg_wa = KIN(kp, 10); const float* rg_wx = KIN(kp, 12); bf16* RGW = (bf16*)(ws + WS_RGW);
          for (int e = bid * (NWAVES * 64) + tid; e < 2 * 8 * 64 * 64; e += G * NWAVES * 64) { const int k = e & 63, n = (e >> 6) & 63, hd = (e >> 12) & 7, g = e >> 15;
              RGW[e] = (bf16)f2bf((g ? rg_wx : rg_wa)[(size_t)(hd * 64 + k) * 64 + n]); } }
        float* XS = (float*)(ws + WS_XS);
        for (int m0 = gw * 4; m0 < NTOK; m0 += NGW * 4) {
            f32x4 v[4][4];
#pragma unroll
            for (int r = 0; r < 4; ++r) { const GAS f32x4* xr = (const GAS f32x4*)(x + (size_t)(m0 + r) * DMODEL) + lane;
#pragma unroll
                for (int j = 0; j < 4; ++j) v[r][j] = __builtin_nontemporal_load(xr + 64 * j); }
#pragma unroll
            for (int r = 0; r < 4; ++r) { float s2 = 0.f;
#pragma unroll
                for (int j = 0; j < 4; ++j) s2 += (v[r][j].x * v[r][j].x + v[r][j].y * v[r][j].y) + (v[r][j].z * v[r][j].z + v[r][j].w * v[r][j].w);
                const float rms = sqrtf(wave_sum(s2) * (1.f / DMODEL) + 1e-6f), rstd = 1.0f / rms;
                if (lane == 0) XS[m0 + r] = rms;
                GAS unsigned long long* o8 = (GAS unsigned long long*)(SLOTA + (size_t)(m0 + r) * DMODEL) + lane;
#pragma unroll
                for (int j = 0; j < 4; ++j) o8[64 * j] = (unsigned long long)pk2(v[r][j].x * rstd, v[r][j].y * rstd) | ((unsigned long long)pk2(v[r][j].z * rstd, v[r][j].w * rstd) << 32); }
        }
        if (BOTH(0) || rep_ == 0 && MK_REP == 0) GRID_BAR();
    }

    if (IN(1)) for (int rep_ = 0; rep_ < 1 + (MK_REP == 1 ? 1 : 0); ++rep_) {
        KARG(kp); unsigned char* ws = KWS(kp);
        bf16* WIN = (bf16*)(ws + WS_WIN); float* ROPE = (float*)(ws + WS_ROPE); bf16* SLOTA = (bf16*)(ws + WS_XN); bf16* PROJ = (bf16*)(ws + WS_PROJ);
        pg8::GSched S{}; S.so.init(NTOK, INW, G, bid); S.A = (const char*)SLOTA; S.a_pm = 256 * 1024 * 2; S.a_pn = 0; S.B = (const char*)WIN; S.b_pn = 256 * 1024 * 2; S.b_e = 0; S.rowidx = nullptr; S.pm0 = 0;
        pg8::EpiInProj E{PROJ, ROPE};
        pg8::gemm_phase2<pg8::EpiInProj, false, true>(lds + RING_OFF, S, 1024, 1024, 1024, E);
        if (BOTH(1) || rep_ == 0 && MK_REP == 1) GRID_BAR();
    }

    if (IN(2)) for (int rep_ = 0; rep_ < 1 + (MK_REP == 2 ? 1 : 0); ++rep_) {
        KARG(kp); unsigned char* ws = KWS(kp);
        const float* lam_q1 = KIN(kp, 3); const float* lam_k1 = KIN(kp, 4); const float* lam_q2 = KIN(kp, 5); const float* lam_k2 = KIN(kp, 6); const float* subln_g = KIN(kp, 7);
        const float* conv_w = KIN(kp, 8); const float* conv_b = KIN(kp, 9); const float* rg_wa = KIN(kp, 10); const float* rg_ba = KIN(kp, 11); const float* rg_wx = KIN(kp, 12); const float* rg_bx = KIN(kp, 13); const float* rg_lam = KIN(kp, 14);
        bf16* AR = (bf16*)(ws + WS_AR); bf16* PROJ = (bf16*)(ws + WS_PROJ);
#ifndef NO_RGLRU
        {
            PHASE_IDS();
            LAS float* XC = (LAS float*)(lds + RING_OFF);
            LAS bf16* XCB = (LAS bf16*)(lds + RING_OFF + 32768);
            LAS float* AA = (LAS float*)(lds + RING_OFF + 51200);
            LAS float* UU = (LAS float*)(lds + RING_OFF + 83968);
            LAS float* CST = (LAS float*)(lds + RING_OFF + 116736);
            LAS float* SP = CST + 192;
            LAS float* SH = SP + 512;
            LAS float* HIN = SH + 512;
            const bf16* RGW = (const bf16*)(ws + WS_RGW);
            gu64* SUMM = (gu64*)(ws + WS_SUMM);
            const int c = tid & 63, s = wave, fr = lane & 15, fq = lane >> 4;
            const int nsl = (G >= 64) ? (G >> 6) : 1;
            for (int chain = (G >= 64) ? (vcu & 63) : vcu; chain < 64 && (G < 64 || vcu < 64 * nsl); chain += (G >= 64) ? 64 : G) {
                const int b = chain >> 3, hd = chain & 7;
                const bf16* xbp = PROJ + (size_t)(b * SEQL) * INW + 1536 + hd * 64 + c;
                const bf16* gbp = PROJ + (size_t)(b * SEQL) * INW + 2048 + hd * 64 + c;
                bf16* rp = AR + (size_t)(b * SEQL) * 1024 + 512 + hd * 64 + c;
                if (tid < 64) { CST[c] = rg_ba[hd * 64 + c]; CST[64 + c] = rg_bx[hd * 64 + c]; CST[128 + c] = -8.0f * 1.4426950408889634f * log1pf(__expf(-rg_lam[hd * 64 + c])); }
                const float cw0 = conv_w[0 * 512 + hd * 64 + c], cw1 = conv_w[1 * 512 + hd * 64 + c], cw2 = conv_w[2 * 512 + hd * 64 + c], cw3 = conv_w[3 * 512 + hd * 64 + c], cb = conv_b[hd * 64 + c];
                bf16x8 wf[2][4][2];
#pragma unroll
                for (int g = 0; g < 2; ++g)
#pragma unroll
                    for (int nb = 0; nb < 4; ++nb)
#pragma unroll
                        for (int ks = 0; ks < 2; ++ks) wf[g][nb][ks] = *(const bf16x8*)(RGW + (size_t)(((g * 8 + hd) * 64 + 16 * nb + fr) * 64 + 32 * ks + 8 * fq));
                float carry = 0.f; int cseg = 0;
#ifdef REP_RGLRU
              for (int rr_ = 0; rr_ < 2; ++rr_) { carry = 0.f; cseg = 0;
#endif
                float xw[19], gbv[16], gbn[16];
                { const int t0 = ((G >= 64) ? (vcu >> 6) : 0) * 128 + s * 16;
#pragma unroll
                  for (int j = 0; j < 19; ++j) { const int t = t0 - 3 + j; xw[j] = (t >= 0) ? bf2f(xbp[(size_t)(t < 0 ? 0 : t) * INW]) : 0.f; }
#pragma unroll
                  for (int i = 0; i < 16; ++i) gbv[i] = bf2f(gbp[(size_t)(t0 + i) * INW]); }
                for (int seg = (G >= 64) ? (vcu >> 6) : 0; seg < 32; seg += nsl) {
                    const int t0 = seg * 128 + s * 16;
#pragma unroll
                    for (int i = 0; i < 16; ++i) { const float v = cb + ((cw0 * xw[i] + cw1 * xw[i + 1]) + (cw2 * xw[i + 2] + cw3 * xw[i + 3])); XC[(s * 16 + i) * 64 + c] = v; XCB[(s * 16 + i) * 72 + c] = (bf16)f2bf(v); }
                    __syncthreads();
                    if (seg + nsl < 32) { const int t0n = (seg + nsl) * 128 + s * 16;
#pragma unroll
                      for (int j = 0; j < 19; ++j) xw[j] = bf2f(xbp[(size_t)(t0n - 3 + j) * INW]);
#pragma unroll
                      for (int i = 0; i < 16; ++i) gbn[i] = bf2f(gbp[(size_t)(t0n + i) * INW]); }
                    {
                        const bf16x8 xf0 = *(const LAS bf16x8*)(XCB + (s * 16 + fr) * 72 + 8 * fq), xf1 = *(const LAS bf16x8*)(XCB + (s * 16 + fr) * 72 + 32 + 8 * fq);
#pragma unroll
                        for (int nb = 0; nb < 4; ++nb) {
                            f32x4 da = (f32x4){0.f, 0.f, 0.f, 0.f}, dx = (f32x4){0.f, 0.f, 0.f, 0.f};
                            da = __builtin_amdgcn_mfma_f32_16x16x32_bf16(wf[0][nb][0], xf0, da, 0, 0, 0); da = __builtin_amdgcn_mfma_f32_16x16x32_bf16(wf[0][nb][1], xf1, da, 0, 0, 0);
                            dx = __builtin_amdgcn_mfma_f32_16x16x32_bf16(wf[1][nb][0], xf0, dx, 0, 0, 0); dx = __builtin_amdgcn_mfma_f32_16x16x32_bf16(wf[1][nb][1], xf1, dx, 0, 0, 0);
                            const int c0 = 16 * nb + 4 * fq, t = s * 16 + fr;
                            const f32x4 ba4 = *(const LAS f32x4*)(CST + c0), bx4 = *(const LAS f32x4*)(CST + 64 + c0), sp4 = *(const LAS f32x4*)(CST + 128 + c0), xc4 = *(const LAS f32x4*)(XC + t * 64 + c0);
                            f32x4 a4, u4;
#pragma unroll
                            for (int j = 0; j < 4; ++j) {
                                const float r = __builtin_amdgcn_rcpf(1.0f + __builtin_amdgcn_exp2f(-1.4426950408889634f * (da[j] + ba4[j])));
                                const float ig = __builtin_amdgcn_rcpf(1.0f + __builtin_amdgcn_exp2f(-1.4426950408889634f * (dx[j] + bx4[j])));
                                const float a = __builtin_amdgcn_exp2f(r * sp4[j]);
                                a4[j] = a; u4[j] = __builtin_amdgcn_sqrtf(fmaxf(1.0f - a * a, 0.f)) * (ig * xc4[j]);
                            }
                            *(LAS f32x4*)(AA + t * 64 + c0) = a4; *(LAS f32x4*)(UU + t * 64 + c0) = u4;
                        }
                    }
                    __syncthreads();
                    float hl[16], cp[16]; float h = 0.f, P = 1.f;
#pragma unroll
                    for (int i = 0; i < 16; ++i) { const float a = AA[(s * 16 + i) * 64 + c], uu = UU[(s * 16 + i) * 64 + c]; h = a * h + uu; P *= a; hl[i] = h; cp[i] = P; }
                    SP[s * 64 + c] = P; SH[s * 64 + c] = h;
                    __syncthreads();
                    if (wave == 0) {
                        float Ps = 1.f, Hs = 0.f;
#pragma unroll
                        for (int s2 = 0; s2 < 8; ++s2) { const float p2 = SP[s2 * 64 + c]; Hs = p2 * Hs + SH[s2 * 64 + c]; Ps *= p2; }
                        const int uidx = chain * 32 + seg;
                        Ps = __uint_as_float(__float_as_uint(Ps) | 1u);
                        __hip_atomic_store(SUMM + (size_t)uidx * 64 + c, ((unsigned long long)__float_as_uint(Hs) << 32) | __float_as_uint(Ps), RLX_AGENT);
                        if (cseg < seg) {
                            for (int s2 = cseg; s2 < seg; s2 += 4) {
                                unsigned long long v[4]; unsigned spins = 0;
                                for (;;) { bool ok = true;
#pragma unroll
                                    for (int j = 0; j < 4; ++j) { v[j] = (s2 + j < seg) ? __hip_atomic_load(SUMM + (size_t)(chain * 32 + s2 + j) * 64 + c, RLX_AGENT) : 0x000000003f800001ull;
                                        ok = ok && ((unsigned)v[j] & 1u); }
                                    if (__all(ok)) break;
                                    __builtin_amdgcn_s_sleep(1);
                                    if (++spins > (1u << 22)) { if (lane == 0) __hip_atomic_store(ctl + CW_TMO, 1u, RLX_AGENT); break; } }
#pragma unroll
                                for (int j = 0; j < 4; ++j) carry = __uint_as_float((unsigned)v[j]) * carry + __uint_as_float((unsigned)(v[j] >> 32)); }
                        }
                        HIN[c] = carry;
                        carry = Ps * carry + Hs; cseg = seg + 1;
                    }
                    __syncthreads();
                    float base = HIN[c];
                    for (int s2 = 0; s2 < s; ++s2) base = SP[s2 * 64 + c] * base + SH[s2 * 64 + c];
#pragma unroll
                    for (int i = 0; i < 16; ++i) { const float hh = hl[i] + cp[i] * base; rp[(size_t)(t0 + i) * 1024] = (bf16)f2bf(hh * gelu_tanh(gbv[i])); }
#pragma unroll
                    for (int i = 0; i < 16; ++i) gbv[i] = gbn[i];
                    __syncthreads();
                }
#ifdef REP_RGLRU
              }
#endif
            }
        }
#endif
#ifndef NO_ATTN
        {
            float lam;
            {   PHASE_IDS();
                const float d1 = wave_sum(lam_q1[lane] * lam_k1[lane]), d2 = wave_sum(lam_q2[lane] * lam_k2[lane]);
                lam = __uint_as_float(__builtin_amdgcn_readfirstlane(__float_as_uint(expf(d1) - expf(d2) + 0.2f))); }
            const attn_body::AttnTensors AT{(const attn_body::bf16*)PROJ, (const attn_body::bf16*)PROJ + 512, (const attn_body::bf16*)PROJ + 1024, (attn_body::bf16*)AR, lam, subln_g};
            const attn_body::StaticOrder SA(G, vcu);
#ifdef REP_ATTN
            for (int ra_ = 0; ra_ < 2; ++ra_)
#endif
#ifdef ATTN_V1
            attn_body::attn_phase<attn_body::StaticOrder>((char*)lds_raw + RING_OFF, AT, SA);
#else
            { const attn_body::StaticOrder2 SA2(G, vcu); attn_body::attn_phase2<attn_body::StaticOrder2>((char*)lds_raw + RING_OFF, AT, SA2); }
#endif
        }
#endif
        if (BOTH(2) || rep_ == 0 && MK_REP == 2) GRID_BAR();
    }


    if (IN(4)) for (int rep_ = 0; rep_ < 1 + (MK_REP == 4 ? 1 : 0); ++rep_) {
        KARG(kp); unsigned char* ws = KWS(kp);
        bf16* WOUT = (bf16*)(ws + WS_WOUT); bf16* XN = (bf16*)(ws + WS_XN); bf16* AR = (bf16*)(ws + WS_AR); bf16* H1B = (bf16*)(ws + WS_H1B); float* SSQ1 = (float*)(ws + WS_SSQ1);
        pg8::GSched S{}; S.so.init(NTOK, 1024, G, bid); S.A = (const char*)AR; S.a_pm = 256 * 1024 * 2; S.B = (const char*)WOUT; S.b_pn = 256 * 1024 * 2;
        pg8::EpiResid<true, false, true, false, true> E{nullptr, XN, nullptr, H1B, SSQ1, nullptr, (const float*)(ws + WS_XS)};
        pg8::gemm_phase2<pg8::EpiResid<true, false, true, false, true>, false, true>(lds + RING_OFF, S, 1024, 1024, 1024, E);
        if (BOTH(4) || rep_ == 0 && MK_REP == 4) GRID_BAR();
    }

    if (IN(5)) for (int rep_ = 0; rep_ < 1 + (MK_REP == 5 ? 1 : 0); ++rep_) {
        KARG(kp); unsigned char* ws = KWS(kp);
        bf16* WF1 = (bf16*)(ws + WS_WF1); bf16* H1B = (bf16*)(ws + WS_H1B); bf16* HID = (bf16*)(ws + WS_HID); float* SSQ1 = (float*)(ws + WS_SSQ1);
        pg8::GSched S{}; S.so.init(NTOK, 2 * FFND, G, bid); S.A = (const char*)H1B; S.a_pm = 256 * 1024 * 2; S.B = (const char*)WF1; S.b_pn = 256 * 1024 * 2;
        pg8::EpiSwiGLU8T<true> E{(unsigned char*)HID, FFND, 8.0f, SSQ1};
        pg8::gemm_phase2<pg8::EpiSwiGLU8T<true>, false, true>(lds + RING_OFF, S, 1024, 1024, 1024, E);
        if (BOTH(5) || rep_ == 0 && MK_REP == 5) GRID_BAR();
    }

    if (IN(6)) for (int rep_ = 0; rep_ < 1 + (MK_REP == 6 ? 1 : 0); ++rep_) {
        KARG(kp); unsigned char* ws = KWS(kp);
        bf16* WF2 = (bf16*)(ws + WS_WF2); bf16* HID = (bf16*)(ws + WS_HID); bf16* H1B = (bf16*)(ws + WS_H1B); float* SSQ2 = (float*)(ws + WS_SSQ2);
        pg8::GSched S{}; S.so.init(NTOK, 1024, G, bid); S.A = (const char*)HID; S.a_pm = 256 * FFND; S.B = (const char*)WF2; S.b_pn = 256 * FFND;
        pg8::EpiResid<true, false, true> E{nullptr, H1B, nullptr, H1B, SSQ2, nullptr, nullptr};
        pg8::gemm_phase2<pg8::EpiResid<true, false, true>, false, true, true>(lds + RING_OFF, S, FFND / 2, FFND / 2, FFND / 2, E, 121, 124);
        if (BOTH(6) || rep_ == 0 && MK_REP == 6) GRID_BAR();
    }

    if (IN(7)) for (int rep_ = 0; rep_ < 1 + (MK_REP == 7 ? 1 : 0); ++rep_) {
        PHASE_IDS(); KARG(kp); unsigned char* ws = KWS(kp); const bf16* HB = (const bf16*)(ws + WS_H1B);
        bf16* SLOTA = (bf16*)(ws + WS_XN); float* SSQ2 = (float*)(ws + WS_SSQ2);
        LAS float* RS = (LAS float*)(lds + RING_OFF);
        for (int blk = bid; blk < NTOK / 128; blk += G) {
            const int t0 = blk * 128, pos0 = t0 & (SEQL - 1);
            if (tid < 144) { const int row = t0 - 16 + tid; float rs = 0.f;
                if (row >= 0) { const f32x4* sp = (const f32x4*)(SSQ2 + (size_t)row * 16); const f32x4 t = (sp[0] + sp[1]) + (sp[2] + sp[3]); rs = 1.0f / sqrtf(((t[0] + t[1]) + (t[2] + t[3])) * (1.0f / 1024.0f) + 1e-6f); }
                RS[tid] = rs; }
            __syncthreads();
            const int w = 2 << (tid >> 7);
            const bf16* hp = HB + 2 * tid;
#define LD2(p) ({ const unsigned u_ = *(const unsigned*)(p); make_float2(__uint_as_float(u_ << 16), __uint_as_float(u_ & 0xffff0000u)); })
            float s0 = 0.f, s1 = 0.f;
            for (int j = 1; j <= 16; ++j) if (j <= w && pos0 - j >= 0) { const float2 v = LD2(hp + (size_t)(t0 - j) * 1024); const float rs = RS[16 - j]; s0 += v.x * rs; s1 += v.y * rs; }
            for (int i0 = 0; i0 < 128; i0 += 8) {
                float2 vn[8], vo[8];
#pragma unroll
                for (int i = 0; i < 8; ++i) { vn[i] = LD2(hp + (size_t)(t0 + i0 + i) * 1024); const int ro = t0 + i0 + i - w; vo[i] = (pos0 + i0 + i - w >= 0) ? LD2(hp + (size_t)(ro < 0 ? 0 : ro) * 1024) : make_float2(0.f, 0.f); }
#pragma unroll
                for (int i = 0; i < 8; ++i) {
                    const int pos = pos0 + i0 + i; const float rs = RS[16 + i0 + i];
                    const float a0 = vn[i].x * rs, a1 = vn[i].y * rs;
                    s0 += a0; s1 += a1;
                    if (pos - w >= 0) { const float ro = RS[16 + i0 + i - w]; s0 -= vo[i].x * ro; s1 -= vo[i].y * ro; }
                    const float ic = 1.0f / (float)((pos + 1 < w) ? pos + 1 : w);
                    *(GAS unsigned*)(SLOTA + (size_t)(t0 + i0 + i) * 1024 + 2 * tid) = pk2(s0 * ic - a0, s1 * ic - a1);
                }
            }
            __syncthreads();
        }
#undef LD2
        if (BOTH(7) || rep_ == 0 && MK_REP == 7) GRID_BAR();
    }

    if (IN(8)) for (int rep_ = 0; rep_ < 1 + (MK_REP == 8 ? 1 : 0); ++rep_) {
        KARG(kp); unsigned char* ws = KWS(kp); bf16* HB = (bf16*)(ws + WS_H1B); const float* pool_scale = KIN(kp, 22);
        bf16* SLOTA = (bf16*)(ws + WS_XN); bf16* WPL = (bf16*)(ws + WS_WPL);
        pg8::GSched S{}; S.so.init(NTOK, 1024, G, bid); S.A = (const char*)SLOTA; S.a_pm = 256 * 1024 * 2; S.a_pn = 512; S.B = (const char*)WPL; S.b_pn = 256 * 256 * 2;
        pg8::EpiPool E{HB, pool_scale};
        pg8::gemm_phase2<pg8::EpiPool, false, true>(lds + RING_OFF, S, 256, 1024, 256, E);
        if (BOTH(8) || rep_ == 0 && MK_REP == 8) GRID_BAR();
    }

    if (IN(9)) for (int rep_ = 0; rep_ < 1 + (MK_REP == 9 ? 1 : 0); ++rep_) {
        PHASE_IDS(); KARG(kp); unsigned char* ws = KWS(kp); const bf16* HB = (const bf16*)(ws + WS_H1B); const float* ln_ffn_odd = KIN(kp, 23); const float* router_w = KIN(kp, 24);
        bf16* SLOTA = (bf16*)(ws + WS_SLOTA); v4u* TOPK = (v4u*)(ws + WS_TOPK); int* CNT = (int*)(ws + WS_CNT);
        LAS float* GW = (LAS float*)(lds + RING_OFF);
        LAS int* LC = (LAS int*)(lds + RING_OFF + 32768);
        for (int i = tid; i < 8192; i += NWAVES * 64) GW[i] = ln_ffn_odd[i >> 3] * router_w[i];
        __syncthreads();
        for (int blk = bid; blk < NTOK / 128; blk += G) {
            if (tid < 8) LC[tid] = 0;
            __syncthreads();
            for (int r0 = wave * 4; r0 < 128; r0 += NWAVES * 4) {
                f32x4 v[4][4]; float ss[4]; float lg[4][8];
#pragma unroll
                for (int r = 0; r < 4; ++r) { const GAS unsigned long long* xr = (const GAS unsigned long long*)(HB + (size_t)(blk * 128 + r0 + r) * DMODEL) + lane;
#pragma unroll
                    for (int j = 0; j < 4; ++j) { const unsigned long long hw = __builtin_nontemporal_load(xr + 64 * j); const unsigned h0 = (unsigned)hw, h1 = (unsigned)(hw >> 32);
                        v[r][j].x = __uint_as_float(h0 << 16); v[r][j].y = __uint_as_float(h0 & 0xffff0000u); v[r][j].z = __uint_as_float(h1 << 16); v[r][j].w = __uint_as_float(h1 & 0xffff0000u); }
                    ss[r] = 0.f;
#pragma unroll
                    for (int e = 0; e < 8; ++e) lg[r][e] = 0.f; }
#pragma unroll
                for (int j = 0; j < 4; ++j) {
                    const LAS f32x4* gp = (const LAS f32x4*)(GW + (size_t)(4 * (lane + 64 * j)) * 8);
#pragma unroll
                    for (int q = 0; q < 4; ++q) { const f32x4 ga = gp[2 * q], gb = gp[2 * q + 1];
#pragma unroll
                        for (int r = 0; r < 4; ++r) { const float xv = v[r][j][q]; ss[r] += xv * xv;
                            lg[r][0] += xv * ga.x; lg[r][1] += xv * ga.y; lg[r][2] += xv * ga.z; lg[r][3] += xv * ga.w; lg[r][4] += xv * gb.x; lg[r][5] += xv * gb.y; lg[r][6] += xv * gb.z; lg[r][7] += xv * gb.w; } } }
#pragma unroll
                for (int r = 0; r < 4; ++r) {
                    const int m = blk * 128 + r0 + r;
                    const float sst = wave_sum(ss[r]); float l[8];
#pragma unroll
                    for (int e = 0; e < 8; ++e) l[e] = wave_sum(lg[r][e]);
                    const float rstd = 1.0f / sqrtf(sst * (1.f / DMODEL) + 1e-6f);
                    int e1 = 0; float l1 = l[0];
#pragma unroll
                    for (int e = 1; e < 8; ++e) if (l[e] > l1) { l1 = l[e]; e1 = e; }
                    int e2 = -1; float l2 = -3.0e38f;
#pragma unroll
                    for (int e = 0; e < 8; ++e) if (e != e1 && l[e] > l2) { l2 = l[e]; e2 = e; }
                    const float g1 = 1.0f / (1.0f + expf((l2 - l1) * rstd)), g2 = 1.0f - g1;
                    GAS unsigned* o4 = (GAS unsigned*)((unsigned char*)SLOTA + (size_t)m * DMODEL) + lane;
                    const float r4 = rstd * 4.0f;
#pragma unroll
                    for (int j = 0; j < 4; ++j) o4[64 * j] = pg8::cvt4_fp8(v[r][j].x * r4, v[r][j].y * r4, v[r][j].z * r4, v[r][j].w * r4);
                    if (lane == 0) { v4u tk; tk.x = (unsigned)e1; tk.y = (unsigned)e2; tk.z = __builtin_bit_cast(unsigned, g1); tk.w = __builtin_bit_cast(unsigned, g2); TOPK[m] = tk;
                        atomicAdd((int*)(LC + e1), 1); atomicAdd((int*)(LC + e2), 1); }
                }
            }
            __syncthreads();
            if (tid < 8) CNT[blk * 8 + tid] = LC[tid];
            __syncthreads();
        }
        if (BOTH(9) || rep_ == 0 && MK_REP == 9) GRID_BAR();
    }

    if (IN(10)) for (int rep_ = 0; rep_ < 1 + (MK_REP == 10 ? 1 : 0); ++rep_) {
        PHASE_IDS(); KARG(kp); unsigned char* ws = KWS(kp);
        v4u* TOPK = (v4u*)(ws + WS_TOPK); int* CNT = (int*)(ws + WS_CNT); int* STOK = (int*)(ws + WS_STOK); int* SSLOT = (int*)(ws + WS_SSLOT); float* SGATE = (float*)(ws + WS_SGATE); int* TINFO = (int*)(ws + WS_TINFO);
        LAS int* LCNT = (LAS int*)(lds + RING_OFF);
        LAS int* LE = LCNT + 2048;
        LAS float* LG = (LAS float*)(LE + 256);
        LAS int* LT = (LAS int*)(LG + 256);
        LAS int* PT = LT + 32;
        LAS int* WC = PT + 1024;
        for (int blk = bid; blk < NTOK / 128; blk += G) {
            for (int i = tid; i < 2048; i += NWAVES * 64) LCNT[i] = CNT[i];
            if (tid < 128) { const v4u tk = TOPK[blk * 128 + tid]; const unsigned tz = tk.z, tw = tk.w;
                LE[2 * tid] = (int)tk.x; LE[2 * tid + 1] = (int)tk.y; LG[2 * tid] = __uint_as_float(tz); LG[2 * tid + 1] = __uint_as_float(tw); }
            __syncthreads();
            { const int e = tid & 7, q = tid >> 3; int t = 0, p = 0;
#pragma unroll
              for (int j = 0; j < 4; ++j) { const int b2 = 4 * q + j; const int c = LCNT[b2 * 8 + e]; t += c; if (b2 < blk) p += c; }
              PT[q * 8 + e] = t; PT[512 + q * 8 + e] = p; }
            int myE = -1, rankw = 0;
            if (tid < 256) {
                myE = LE[tid];
#pragma unroll
                for (int ee = 0; ee < 8; ++ee) { const unsigned long long mk = __ballot(myE == ee);
                    if (myE == ee) rankw = __popcll(mk & ((1ull << lane) - 1ull));
                    if (lane == 0) WC[wave * 8 + ee] = __popcll(mk); }
            }
            __syncthreads();
            if (tid < 8) { int t = 0, p = 0; for (int q = 0; q < 64; ++q) { t += PT[q * 8 + tid]; p += PT[512 + q * 8 + tid]; } LT[tid] = t; LT[8 + tid] = p; }
            __syncthreads();
            if (tid < 8) { int base = 0; for (int e2 = 0; e2 < tid; ++e2) base += (LT[e2] + 255) & ~255; LT[16 + tid] = base; }
            __syncthreads();
            if (tid < 256 && myE >= 0) {
                int pos = LT[16 + myE] + LT[8 + myE] + rankw;
                for (int w2 = 0; w2 < wave; ++w2) pos += WC[w2 * 8 + myE];
                STOK[pos] = blk * 128 + (tid >> 1); SSLOT[pos] = 2 * (blk * 128) + tid; SGATE[pos] = LG[tid];
            }
            if (blk == 0) {
                for (int e = 0; e < 8; ++e) { const int base = LT[16 + e], tot = LT[e], padded = (tot + 255) & ~255;
                    for (int q = base + tot + tid; q < base + padded; q += NWAVES * 64) { STOK[q] = 0; SSLOT[q] = -1; SGATE[q] = 0.f; }
                    if (tid == 0) { TINFO[1 + e] = base >> 8; if (e == 7) { TINFO[9] = (base + padded) >> 8; TINFO[0] = (base + padded) >> 8; } } }
            }
            __syncthreads();
        }
        if (BOTH(10) || rep_ == 0 && MK_REP == 10) GRID_BAR();
    }

    if (IN(11)) for (int rep_ = 0; rep_ < 1 + (MK_REP == 11 ? 1 : 0); ++rep_) {
        KARG(kp); unsigned char* ws = KWS(kp); const int* TINFO = (const int*)(ws + WS_TINFO);
        int ti[10];
#pragma unroll
        for (int j = 0; j < 10; ++j) ti[j] = __builtin_amdgcn_readfirstlane(TINFO[j]);
        int nM = ti[0]; if (nM > MAXTILES) nM = MAXTILES;
        if (nM > 0) {
            pg8::GSched S{}; S.so.init(nM * 256, 2 * EDIM, G, bid); S.A = (const char*)(ws + WS_SLOTA); S.a_pm = 0; S.a_pn = 0; S.B = (const char*)(ws + WS_WM1); S.b_pn = 256 * 1024; S.b_e = 7168 * 1024;
#pragma unroll
            for (int j = 0; j < 9; ++j) S.tb[j] = ti[1 + j];
            S.rowidx = (const int*)(ws + WS_STOK); S.pm0 = 0;
            pg8::EpiSwiGLU8 E{ws + WS_HIDS, EDIM, 8.0f, nullptr};
            pg8::gemm_phase2<pg8::EpiSwiGLU8, true, true, true>(lds + RING_OFF, S, 512, 512, 512, E, 122, 125);
        }
        if (BOTH(11) || rep_ == 0 && MK_REP == 11) GRID_BAR();
    }
    if (IN(12)) for (int rep_ = 0; rep_ < 1 + (MK_REP == 12 ? 1 : 0); ++rep_) {
        KARG(kp); unsigned char* ws = KWS(kp); const int* TINFO = (const int*)(ws + WS_TINFO);
        int ti[10];
#pragma unroll
        for (int j = 0; j < 10; ++j) ti[j] = __builtin_amdgcn_readfirstlane(TINFO[j]);
        int nM = ti[0]; if (nM > MAXTILES) nM = MAXTILES;
        if (nM > 0) {
            pg8::GSched S{}; S.so.init(nM * 256, 1024, G, bid); S.A = (const char*)(ws + WS_HIDS); S.a_pm = 256 * EDIM; S.a_pn = 0; S.B = (const char*)(ws + WS_WM2); S.b_pn = 256 * EDIM; S.b_e = 1024 * EDIM;
#pragma unroll
            for (int j = 0; j < 9; ++j) S.tb[j] = ti[1 + j];
            S.rowidx = nullptr; S.pm0 = 0;
            pg8::EpiScatter E{ws + WS_Y, (const int*)(ws + WS_SSLOT), (const float*)(ws + WS_SGATE), 0};
            pg8::gemm_phase2<pg8::EpiScatter, false, true, true>(lds + RING_OFF, S, EDIM / 2, EDIM / 2, EDIM / 2, E, 121, 124);
        }
        if (BOTH(12) || rep_ == 0 && MK_REP == 12) GRID_BAR();
    }

    if (IN(PH_FINAL)) {
        PHASE_IDS(); KARG(kp); unsigned char* ws = KWS(kp); float* H = KOUT(kp); const bf16* HB = (const bf16*)(ws + WS_H1B); const float* final_g = KIN(kp, 28); const unsigned char* YB = ws + WS_Y;
        unsigned poison = __hip_atomic_load(ctl + CW_BAR + XB_TMO, RLX_AGENT);
        for (int m0 = gw * 2; m0 < NTOK; m0 += NGW * 2) {
            f32x4 v[2][4]; unsigned ya[2][4], yb[2][4]; unsigned long long hw[2][4];
#pragma unroll
            for (int r = 0; r < 2; ++r) { const int m = m0 + r;
                const GAS unsigned long long* xr = (const GAS unsigned long long*)(HB + (size_t)m * DMODEL) + lane;
                const GAS unsigned* y0 = (const GAS unsigned*)(YB + (size_t)(2 * m) * DMODEL) + lane;
                const GAS unsigned* y1 = (const GAS unsigned*)(YB + (size_t)(2 * m + 1) * DMODEL) + lane;
#pragma unroll
                for (int j = 0; j < 4; ++j) { hw[r][j] = __builtin_nontemporal_load(xr + 64 * j); ya[r][j] = __builtin_nontemporal_load(y0 + 64 * j); yb[r][j] = __builtin_nontemporal_load(y1 + 64 * j); } }
#pragma unroll
            for (int r = 0; r < 2; ++r) { float s = 0.f;
#pragma unroll
                for (int j = 0; j < 4; ++j) { const unsigned a = ya[r][j], b = yb[r][j];
                    { const unsigned long long hq = hw[r][j]; const unsigned h0 = (unsigned)hq, h1 = (unsigned)(hq >> 32);
                      v[r][j].x = __uint_as_float(h0 << 16); v[r][j].y = __uint_as_float(h0 & 0xffff0000u); v[r][j].z = __uint_as_float(h1 << 16); v[r][j].w = __uint_as_float(h1 & 0xffff0000u); }
                    const auto al = __builtin_amdgcn_cvt_pk_f32_fp8((int)a, false), ah = __builtin_amdgcn_cvt_pk_f32_fp8((int)a, true);
                    const auto bl = __builtin_amdgcn_cvt_pk_f32_fp8((int)b, false), bh = __builtin_amdgcn_cvt_pk_f32_fp8((int)b, true);
                    v[r][j].x += (al[0] + bl[0]) * 0.0625f; v[r][j].y += (al[1] + bl[1]) * 0.0625f; v[r][j].z += (ah[0] + bh[0]) * 0.0625f; v[r][j].w += (ah[1] + bh[1]) * 0.0625f;
                    s += (v[r][j].x * v[r][j].x + v[r][j].y * v[r][j].y) + (v[r][j].z * v[r][j].z + v[r][j].w * v[r][j].w); }
                float rstd = 1.0f / sqrtf(wave_sum(s) * (1.f / DMODEL) + 1e-6f);
                if (poison) rstd = __builtin_nanf("");
                GAS f32x4* xo = (GAS f32x4*)(H + (size_t)(m0 + r) * DMODEL) + lane;
#pragma unroll
                for (int j = 0; j < 4; ++j) { const f32x4 g = *(const f32x4*)(final_g + 4 * (lane + 64 * j)); __builtin_nontemporal_store(v[r][j] * rstd * g, xo + 64 * j); } }
        }
    }
#undef IN
#undef BOTH
#undef GRID_BAR
}


#ifndef MK_MAXPH
#define MK_MAXPH PH_END
#endif
#ifndef MK_PER_PHASE
#define MK_PER_PHASE 0
#endif
extern "C" void kernel_launch(void* const* d_in, const int* in_sizes, int n_in, void* d_out, int out_size, void* d_ws, size_t ws_size, hipStream_t stream) {
    static int grid = 0;
    if (grid == 0) {
        if (n_in != 29 || in_sizes[0] != NTOK * DMODEL || out_size != NTOK * DMODEL || ws_size < WS_END) { fprintf(stderr, "kernel_launch: unexpected shapes / workspace (%d inputs, ws %zu); nothing launched\n", n_in, ws_size); grid = -1; return; }
        int dev = 0, cus = 0, per_cu = 0;
        if (hipGetDevice(&dev) != hipSuccess || hipDeviceGetAttribute(&cus, hipDeviceAttributeMultiprocessorCount, dev) != hipSuccess) { grid = -1; return; }
        if (hipFuncSetAttribute((const void*)mk_fwd, hipFuncAttributeMaxDynamicSharedMemorySize, LDS_BYTES) != hipSuccess) { fprintf(stderr, "kernel_launch: hipFuncSetAttribute failed\n"); grid = -1; return; }
        if (hipOccupancyMaxActiveBlocksPerMultiprocessor(&per_cu, (const void*)mk_fwd, NWAVES * 64, LDS_BYTES) != hipSuccess || per_cu < 1) { fprintf(stderr, "kernel_launch: occupancy query reports %d\n", per_cu); }
        (void)hipGetLastError();
        grid = cus;
    }
    if (grid < 0) return;
    if (hipMemsetAsync((char*)d_ws + WS_CTL, 0, CTL_ZERO_BYTES, stream) != hipSuccess) return;
    Args a{};
    for (int i = 0; i < 29; ++i) a.in[i] = (const float*)d_in[i];
    a.out = (float*)d_out; a.ws = (unsigned char*)d_ws;
#if MK_PER_PHASE
    for (int p = 0; p < MK_MAXPH; ++p) { a.ph_lo = p; a.ph_hi = p + 1; hipLaunchKernelGGL(mk_fwd, dim3(grid), dim3(NWAVES * 64), LDS_BYTES, stream, a); }
#else
    a.ph_lo = 0; a.ph_hi = PH_END; hipLaunchKernelGGL(mk_fwd, dim3(grid), dim3(NWAVES * 64), LDS_BYTES, stream, a);
#endif
}
```

```cpp
#include <hip/hip_runtime.h>
#include <hip/hip_bf16.h>
#include <cstdio>
#include <cstdint>
#include <cmath>
namespace pg8 {
#define PG8_LAS __attribute__((address_space(3)))
typedef unsigned short bf16_t;
typedef short bf16x8 __attribute__((ext_vector_type(8)));
typedef float f32x4 __attribute__((ext_vector_type(4)));
typedef unsigned u32x4 __attribute__((ext_vector_type(4)));
typedef unsigned u32x2 __attribute__((ext_vector_type(2)));
typedef float f32x2 __attribute__((ext_vector_type(2)));
typedef int i32x4 __attribute__((ext_vector_type(4)));
typedef int i32x8 __attribute__((ext_vector_type(8)));
constexpr int BM = 256, BK = 64, HALF = 128, HTB = HALF * BK * 2  , STAGE_BYTES = 8 * HTB, NXCD = 8, WGM = 4;

__host__ __device__ __forceinline__ int lds_byte(int r, int c) { const int st = (r >> 4) * 2 + (c >> 5), rr = r & 15, cc = c & 31, ob = rr * 64 + cc * 2; return st * 1024 + (ob ^ (((ob >> 9) & 1) << 5)); }
__host__ __device__ __forceinline__ void stage_rc(int b, int& R, int& C) { const int st = b / 1024, sb = b % 1024, swz = sb ^ (((sb >> 9) & 1) << 5); R = (st >> 1) * 16 + swz / 64; C = (st & 1) * 32 + (swz % 64) / 2; }
__host__ __device__ __forceinline__ int perm32(int rho) { const int n = rho >> 4, i = rho & 15; return 8 * (i >> 2) + 4 * n + (i & 3); }

struct Unit { int pm, pn; };

struct StaticOrder {
    int nM, nN, nwg, G, c;
    __host__ __device__ void init(int M, int N, int G_, int c_) { nM = M / BM; nN = N / BM; nwg = nM * nN; G = G_; c = c_; }
    __host__ __device__ bool next(int i, Unit& u) const {
        const long L = (long)i * G + c; if (L >= nwg) return false;
        int wgid = (int)L; { const int q = nwg / NXCD, r = nwg % NXCD, xcd = wgid % NXCD, off = wgid / NXCD; wgid = (xcd < r ? xcd * (q + 1) : r * (q + 1) + (xcd - r) * q) + off; }
        const int nig = WGM * nN, gid = wgid / nig, fm = gid * WGM, gsz = (nM - fm) < WGM ? (nM - fm) : WGM;
        u.pm = fm + ((wgid % nig) % gsz); u.pn = (wgid % nig) / gsz; return true;
    }
};
struct GSched {
    StaticOrder so;
    const char* A; unsigned a_pm, a_pn;
    const char* B; unsigned b_pn, b_e;
    int tb[9];
    const int* rowidx; int pm0;
    __device__ __forceinline__ bool next(int i, Unit& u) const { return so.next(i, u); }
    __device__ __forceinline__ const char* a_ptr(const Unit& u) const { return A + (size_t)u.pm * a_pm + (size_t)u.pn * a_pn; }
    __device__ __forceinline__ const char* b_ptr(const Unit& u) const {
        size_t off = (size_t)u.pn * b_pn;
        if (b_e) { const int t = pm0 + u.pm; int e = 0;
#pragma unroll
            for (int j = 1; j < 8; ++j) e += (t >= tb[j]) ? 1 : 0;
            off += (size_t)e * b_e; }
        return B + off;
    }
};

__device__ __forceinline__ unsigned cvt_pk_bf16(float lo, float hi) { unsigned r; asm volatile("v_cvt_pk_bf16_f32 %0, %1, %2" : "=v"(r) : "v"(lo), "v"(hi)); return r; }

constexpr float C2 = 0.125f * 1.4426950408889634f;

struct EpiInProj {
    static constexpr bool PERM = true;
    bf16_t* O; const float* rope;
    __device__ __forceinline__ void operator()(const f32x4 (&acc)[2][2][4][2], const Unit& u, int wr, int wc, int fr, int fq) const {
        const int row0 = u.pm * BM + wr * 64 + fr, col0 = u.pn * BM + wc * 32 + 8 * fq;
        const float sc = (u.pn < 2) ? C2 : 1.f;
        const bool ropew = (u.pn < 4) && ((wc & 1) == 0);
        const float sgn = (fq == 0) ? -1.f : 1.f;
#pragma unroll
        for (int ai = 0; ai < 2; ++ai)
#pragma unroll
            for (int m = 0; m < 4; ++m) {
                const int row = row0 + ai * HALF + m * 16; bf16_t* rowp = O + (size_t)row * 2560 + col0;
                f32x4 cs[4];
                if (ropew) { const f32x4* tp = (const f32x4*)(rope + (size_t)(row & 4095) * 16); cs[0] = tp[0]; cs[1] = tp[1]; cs[2] = tp[2]; cs[3] = tp[3]; }
#pragma unroll
                for (int bj = 0; bj < 2; ++bj) {
                    f32x4 v0 = acc[ai][bj][m][0], v1 = acc[ai][bj][m][1];
                    if (ropew) {
                        f32x4 p0, p1;
#pragma unroll
                        for (int j = 0; j < 4; ++j) { p0[j] = __shfl_xor(v0[j], 16); p1[j] = __shfl_xor(v1[j], 16); }
                        if (fq < 2) {
                            v0[0] = v0[0] * cs[0][0] + sgn * p0[0] * cs[0][1]; v0[1] = v0[1] * cs[0][2] + sgn * p0[1] * cs[0][3];
                            v0[2] = v0[2] * cs[1][0] + sgn * p0[2] * cs[1][1]; v0[3] = v0[3] * cs[1][2] + sgn * p0[3] * cs[1][3];
                            v1[0] = v1[0] * cs[2][0] + sgn * p1[0] * cs[2][1]; v1[1] = v1[1] * cs[2][2] + sgn * p1[1] * cs[2][3];
                            v1[2] = v1[2] * cs[3][0] + sgn * p1[2] * cs[3][1]; v1[3] = v1[3] * cs[3][2] + sgn * p1[3] * cs[3][3];
                        }
                    }
                    v0 = v0 * sc; v1 = v1 * sc;
                    u32x4 w; w.x = cvt_pk_bf16(v0[0], v0[1]); w.y = cvt_pk_bf16(v0[2], v0[3]); w.z = cvt_pk_bf16(v1[0], v1[1]); w.w = cvt_pk_bf16(v1[2], v1[3]);
                    *(u32x4*)(rowp + bj * HALF) = w;
                }
            }
    }
};
__device__ __forceinline__ unsigned cvt4_fp8(float a, float b, float c, float d);
template <bool BF16OUT, bool F32OUT, bool BF16RES, bool FP8OUT = false, bool ROWSCALE = false> struct EpiResid {
    static constexpr bool PERM = false;
    const float* res; const bf16_t* resb; float* out; bf16_t* ob; float* ssq; unsigned char* oq; const float* rsc;
    __device__ __forceinline__ void operator()(const f32x4 (&acc)[2][2][4][2], const Unit& u, int wr, int wc, int fr, int fq) const {
        const int row0 = u.pm * BM + wr * 64 + fr, col0 = u.pn * BM + wc * 32 + 4 * fq;
#pragma unroll
        for (int ai = 0; ai < 2; ++ai)
#pragma unroll
            for (int m = 0; m < 4; ++m) {
                const int row = row0 + ai * HALF + m * 16; const size_t off = (size_t)row * 1024 + col0; float ss = 0.f; float rsv = 1.f;
                if (ROWSCALE) rsv = rsc[row];
#pragma unroll
                for (int bj = 0; bj < 2; ++bj)
#pragma unroll
                    for (int n = 0; n < 2; ++n) {
                        const size_t o = off + bj * HALF + n * 16;
                        f32x4 r;
                        if (BF16RES) { const u32x2 rb = *(const u32x2*)(resb + o); r[0] = __uint_as_float(rb.x << 16); r[1] = __uint_as_float(rb.x & 0xffff0000u); r[2] = __uint_as_float(rb.y << 16); r[3] = __uint_as_float(rb.y & 0xffff0000u); if (ROWSCALE) r = r * rsv; }
                        else r = *(const f32x4*)(res + o);
                        const f32x4 v = acc[ai][bj][m][n] + r;
                        if (F32OUT) *(f32x4*)(out + o) = v;
                        ss += (v[0] * v[0] + v[1] * v[1]) + (v[2] * v[2] + v[3] * v[3]);
                        if (BF16OUT) { u32x2 w; w.x = cvt_pk_bf16(v[0], v[1]); w.y = cvt_pk_bf16(v[2], v[3]); *(u32x2*)(ob + o) = w; }
                        if (FP8OUT) *(unsigned*)(oq + o) = cvt4_fp8(v[0] * 4.f, v[1] * 4.f, v[2] * 4.f, v[3] * 4.f);
                    }
                ss += __shfl_xor(ss, 16); ss += __shfl_xor(ss, 32);
                if (fq == 0) ssq[(size_t)row * 16 + u.pn * 4 + wc] = ss;
                if (m & 1) asm volatile("" ::: "memory");
            }
    }
};
template <bool RSTD> struct EpiSwiGLU {
    static constexpr bool PERM = true;
    bf16_t* O; int ldc; const float* ssq;
    __device__ __forceinline__ void operator()(const f32x4 (&acc)[2][2][4][2], const Unit& u, int wr, int wc, int fr, int fq) const {
        const int row0 = u.pm * BM + wr * 64 + fr, col0 = u.pn * HALF + wc * 32 + 8 * fq;
#pragma unroll
        for (int ai = 0; ai < 2; ++ai)
#pragma unroll
            for (int m = 0; m < 4; ++m) {
                const int row = row0 + ai * HALF + m * 16; float rs = 1.f;
                if (RSTD) { const f32x4* sp = (const f32x4*)(ssq + (size_t)row * 16); const f32x4 a = sp[0], b = sp[1], c = sp[2], d = sp[3];
                    const f32x4 t = (a + b) + (c + d); rs = __builtin_amdgcn_rsqf(((t[0] + t[1]) + (t[2] + t[3])) * (1.0f / 1024.0f) + 1e-6f); }
                float h[8];
#pragma unroll
                for (int n = 0; n < 2; ++n)
#pragma unroll
                    for (int j = 0; j < 4; ++j) { const float g = acc[ai][0][m][n][j] * rs, up = acc[ai][1][m][n][j] * rs;
                        h[n * 4 + j] = g * __builtin_amdgcn_rcpf(1.0f + __expf(-g)) * up; }
                u32x4 w; w.x = cvt_pk_bf16(h[0], h[1]); w.y = cvt_pk_bf16(h[2], h[3]); w.z = cvt_pk_bf16(h[4], h[5]); w.w = cvt_pk_bf16(h[6], h[7]);
                *(u32x4*)(O + (size_t)row * ldc + col0) = w;
            }
    }
};
__device__ __forceinline__ unsigned cvt4_fp8(float a, float b, float c, float d) {
    a = __builtin_amdgcn_fmed3f(a, -448.f, 448.f); b = __builtin_amdgcn_fmed3f(b, -448.f, 448.f); c = __builtin_amdgcn_fmed3f(c, -448.f, 448.f); d = __builtin_amdgcn_fmed3f(d, -448.f, 448.f);
    int w = 0; w = __builtin_amdgcn_cvt_pk_fp8_f32(a, b, w, false); w = __builtin_amdgcn_cvt_pk_fp8_f32(c, d, w, true); return (unsigned)w;
}
template <bool RSTD> struct EpiSwiGLU8T {
    static constexpr bool PERM = true;
    unsigned char* O; int ldc; float oscale; const float* ssq;
    __device__ __forceinline__ void operator()(const f32x4 (&acc)[2][2][4][2], const Unit& u, int wr, int wc, int fr, int fq) const {
        const int row0 = u.pm * BM + wr * 64 + fr, col0 = u.pn * HALF + wc * 32 + 8 * fq;
#pragma unroll
        for (int ai = 0; ai < 2; ++ai)
#pragma unroll
            for (int m = 0; m < 4; ++m) {
                const int row = row0 + ai * HALF + m * 16; float h[8]; float rs = 1.f;
                if (RSTD) { const f32x4* sp = (const f32x4*)(ssq + (size_t)row * 16); const f32x4 a = sp[0], b = sp[1], c = sp[2], d = sp[3];
                    const f32x4 t = (a + b) + (c + d); rs = __builtin_amdgcn_rsqf(((t[0] + t[1]) + (t[2] + t[3])) * (1.0f / 1024.0f) + 1e-6f); }
                const float us = rs * oscale;
#pragma unroll
                for (int n = 0; n < 2; ++n)
#pragma unroll
                    for (int jp = 0; jp < 2; ++jp) {
                        f32x2 g2 = (f32x2){acc[ai][0][m][n][2 * jp], acc[ai][0][m][n][2 * jp + 1]}, u2 = (f32x2){acc[ai][1][m][n][2 * jp], acc[ai][1][m][n][2 * jp + 1]};
                        if (RSTD) g2 = g2 * rs;
                        u2 = u2 * us;
                        const f32x2 t2 = g2 * (-1.4426950408889634f);
                        f32x2 d2; d2.x = __builtin_amdgcn_exp2f(t2.x); d2.y = __builtin_amdgcn_exp2f(t2.y);
                        d2 = d2 + 1.0f;
                        f32x2 r2; r2.x = __builtin_amdgcn_rcpf(d2.x); r2.y = __builtin_amdgcn_rcpf(d2.y);
                        const f32x2 h2 = (g2 * r2) * u2;
                        h[n * 4 + 2 * jp] = h2.x; h[n * 4 + 2 * jp + 1] = h2.y; }
                u32x2 w; w.x = cvt4_fp8(h[0], h[1], h[2], h[3]); w.y = cvt4_fp8(h[4], h[5], h[6], h[7]);
                *(u32x2*)(O + (size_t)row * ldc + col0) = w;
            }
    }
};
typedef EpiSwiGLU8T<false> EpiSwiGLU8;
struct EpiPool {
    static constexpr bool PERM = false;
    bf16_t* H; const float* scale;
    __device__ __forceinline__ void operator()(const f32x4 (&acc)[2][2][4][2], const Unit& u, int wr, int wc, int fr, int fq) const {
        const int row0 = u.pm * BM + wr * 64 + fr, col0 = u.pn * BM + wc * 32 + 4 * fq;
        f32x4 sv[2][2];
#pragma unroll
        for (int bj = 0; bj < 2; ++bj)
#pragma unroll
            for (int n = 0; n < 2; ++n) sv[bj][n] = *(const f32x4*)(scale + col0 + bj * HALF + n * 16);
#pragma unroll
        for (int ai = 0; ai < 2; ++ai)
#pragma unroll
            for (int m = 0; m < 4; ++m) {
                const size_t off = (size_t)(row0 + ai * HALF + m * 16) * 1024 + col0;
#pragma unroll
                for (int bj = 0; bj < 2; ++bj)
#pragma unroll
                    for (int n = 0; n < 2; ++n) { const size_t o = off + bj * HALF + n * 16; const u32x2 rb = *(const u32x2*)(H + o); f32x4 r; r[0] = __uint_as_float(rb.x << 16); r[1] = __uint_as_float(rb.x & 0xffff0000u); r[2] = __uint_as_float(rb.y << 16); r[3] = __uint_as_float(rb.y & 0xffff0000u);
                        const f32x4 v = r + acc[ai][bj][m][n] * sv[bj][n]; u32x2 w; w.x = cvt_pk_bf16(v[0], v[1]); w.y = cvt_pk_bf16(v[2], v[3]); *(u32x2*)(H + o) = w; }
                if (m & 1) asm volatile("" ::: "memory");
            }
    }
};
struct EpiScatter {
    static constexpr bool PERM = true;
    unsigned char* Y; const int* slot; const float* gate; int pm0;
    __device__ __forceinline__ void operator()(const f32x4 (&acc)[2][2][4][2], const Unit& u, int wr, int wc, int fr, int fq) const {
        const int pos0 = (pm0 + u.pm) * BM + wr * 64 + fr, col0 = u.pn * BM + wc * 32 + 8 * fq;
#pragma unroll
        for (int ai = 0; ai < 2; ++ai)
#pragma unroll
            for (int m = 0; m < 4; ++m) {
                const int pos = pos0 + ai * HALF + m * 16; const int s = slot[pos]; const float g = gate[pos] * 16.0f;
                if (s >= 0) {
#pragma unroll
                    for (int bj = 0; bj < 2; ++bj) { const f32x4 v0 = acc[ai][bj][m][0] * g, v1 = acc[ai][bj][m][1] * g;
                        u32x2 w; w.x = cvt4_fp8(v0[0], v0[1], v0[2], v0[3]); w.y = cvt4_fp8(v1[0], v1[1], v1[2], v1[3]);
                        *(u32x2*)(Y + (size_t)s * 1024 + col0 + bj * HALF) = w; }
                }
            }
    }
};

template <class Epi, bool GATHER, bool ALIGN_EPI, bool FP8 = false>
__device__ __forceinline__ void gemm_phase2(PG8_LAS unsigned char* lds, const GSched& S, const int K, const int lda, const int ldb, const Epi& E, const int scale_w = 127, const int scale_a = 127) {
    int tid_ = threadIdx.x; asm volatile("" : "+v"(tid_));
    const int tid = tid_, wid = __builtin_amdgcn_readfirstlane(tid >> 6), lane = tid & 63, wr = wid >> 2, wc = wid & 3, fr = lane & 15, fq = lane >> 4;
    const int nt = K / BK;
    int Rr[2], Cc[2]; unsigned voffB[2], voA[2][2], nvoA[2][2];
#pragma unroll
    for (int i = 0; i < 2; ++i) { stage_rc(tid * 16 + i * 8192, Rr[i], Cc[i]); const int Rb = Epi::PERM ? ((Rr[i] & ~31) + perm32(Rr[i] & 31)) : Rr[i];
        voffB[i] = (unsigned)(Rb * ldb + Cc[i]) * 2u;
#pragma unroll
        for (int h = 0; h < 2; ++h) { voA[h][i] = (unsigned)((Rr[i] + h * HALF) * lda + Cc[i]) * 2u; nvoA[h][i] = voA[h][i]; } }
    const size_t kstep = (size_t)(BK * 2);
    const size_t hstepB = (size_t)HALF * ldb * 2;
    const unsigned ldsw = (unsigned)wid * 1024u;
    const int aoff = lds_byte(wr * 64 + fr, fq * (FP8 ? 16 : 8)) + (FP8 ? 16 * (fq & 1) : 0), boff = lds_byte(wc * 32 + fr, fq * (FP8 ? 16 : 8)) + (FP8 ? 16 * (fq & 1) : 0);
    const int aoff2 = aoff ^ 16, boff2 = boff ^ 16;
#define PG8_SA(b, h) (((b) * 2 + (h)) * HTB)
#define PG8_SB(b, h) ((4 + (b) * 2 + (h)) * HTB)
#define PG8_STAGE(bufoff, gbase, voff) do { _Pragma("unroll") for (int _i = 0; _i < 2; ++_i) \
        __builtin_amdgcn_global_load_lds((const unsigned*)((const char*)(gbase) + (voff)[_i]), (PG8_LAS unsigned*)(lds + (bufoff) + ldsw + _i * 8192), 16, 0, 0); } while (0)
#define PG8_CAT(x, y) __builtin_shufflevector((x), (y), 0, 1, 2, 3, 4, 5, 6, 7)
#define PG8_LDA(dst, b, h) do { if constexpr (FP8) { _Pragma("unroll") for (int m = 0; m < 4; ++m) dst##8[m] = PG8_CAT(*(const PG8_LAS i32x4*)(lds + PG8_SA(b, h) + aoff + m * 2048), *(const PG8_LAS i32x4*)(lds + PG8_SA(b, h) + aoff2 + m * 2048)); } \
        else { _Pragma("unroll") for (int m = 0; m < 4; ++m) _Pragma("unroll") for (int k = 0; k < 2; ++k) dst[m][k] = *(const PG8_LAS bf16x8*)(lds + PG8_SA(b, h) + aoff + m * 2048 + k * 1024); } } while (0)
#define PG8_LDB(dst, b, h) do { if constexpr (FP8) { _Pragma("unroll") for (int n = 0; n < 2; ++n) dst##8[n] = PG8_CAT(*(const PG8_LAS i32x4*)(lds + PG8_SB(b, h) + boff + n * 2048), *(const PG8_LAS i32x4*)(lds + PG8_SB(b, h) + boff2 + n * 2048)); } \
        else { _Pragma("unroll") for (int n = 0; n < 2; ++n) _Pragma("unroll") for (int k = 0; k < 2; ++k) dst[n][k] = *(const PG8_LAS bf16x8*)(lds + PG8_SB(b, h) + boff + n * 2048 + k * 1024); } } while (0)
#define PG8_MMA(ai, bj, At, Bt) do { __builtin_amdgcn_s_setprio(1); _Pragma("unroll") for (int m = 0; m < 4; ++m) _Pragma("unroll") for (int n = 0; n < 2; ++n) { \
        if constexpr (FP8) asm volatile("v_mfma_scale_f32_16x16x128_f8f6f4 %0, %1, %2, %0, %3, %4 op_sel_hi:[0,0,0]" : "+v"(acc[ai][bj][m][n]) : "v"(Bt##8[n]), "v"(At##8[m]), "v"(scale_w), "v"(scale_a)); \
        else { _Pragma("unroll") for (int k = 0; k < 2; ++k) acc[ai][bj][m][n] = __builtin_amdgcn_mfma_f32_16x16x32_bf16(Bt[n][k], At[m][k], acc[ai][bj][m][n], 0, 0, 0); } } \
        __builtin_amdgcn_s_setprio(0); } while (0)
#define PG8_WAIT_V(n) asm volatile("s_waitcnt vmcnt(" #n ")" ::: "memory")
#define PG8_WAIT_L(n) asm volatile("s_waitcnt lgkmcnt(" #n ")" ::: "memory")
#define PG8_BAR __builtin_amdgcn_s_barrier()
#define PG8_SCHED __builtin_amdgcn_sched_barrier(0)
#define PG8_GIDX(dst, u) do { if constexpr (GATHER) { _Pragma("unroll") for (int _h = 0; _h < 2; ++_h) _Pragma("unroll") for (int _i = 0; _i < 2; ++_i) \
        dst[_h][_i] = (unsigned)S.rowidx[(S.pm0 + (u).pm) * BM + _h * HALF + Rr[_i]] * (unsigned)(lda * 2) + (unsigned)(Cc[_i] * 2); } } while (0)
    Unit cur, nxt; int ui = 0;
    if (!S.next(0, cur)) return;
    f32x4 acc[2][2][4][2];
#pragma unroll
    for (int a = 0; a < 2; ++a)
#pragma unroll
        for (int b = 0; b < 2; ++b)
#pragma unroll
            for (int m = 0; m < 4; ++m)
#pragma unroll
                for (int n = 0; n < 2; ++n) acc[a][b][m][n] = (f32x4){0.f, 0.f, 0.f, 0.f};
    bf16x8 At[4][2], B0[2][2], B1[2][2];
    i32x8 At8[4], B08[2], B18[2];
    (void)At; (void)B0; (void)B1; (void)At8; (void)B08; (void)B18; (void)aoff2; (void)boff2;
    const char* cA = S.a_ptr(cur); const char* cB = S.b_ptr(cur);
    PG8_GIDX(voA, cur);
    PG8_STAGE(PG8_SB(0, 0), cB, voffB); PG8_STAGE(PG8_SB(0, 1), cB + hstepB, voffB); PG8_STAGE(PG8_SA(0, 0), cA, voA[0]); PG8_STAGE(PG8_SA(0, 1), cA, voA[1]);
    if (wr == 1) PG8_BAR;
    PG8_WAIT_V(2); PG8_BAR;
    PG8_STAGE(PG8_SB(1, 0), cB + kstep, voffB); PG8_STAGE(PG8_SA(1, 0), cA + kstep, voA[0]); PG8_STAGE(PG8_SB(1, 1), cB + hstepB + kstep, voffB);
    PG8_WAIT_V(6); PG8_BAR;
    for (;;) {
        const bool has_next = S.next(ui + 1, nxt);
        const char* nA = has_next ? S.a_ptr(nxt) : cA; const char* nB = has_next ? S.b_ptr(nxt) : cB;
        if constexpr (GATHER) { if (has_next) { PG8_GIDX(nvoA, nxt); } else {
#pragma unroll
            for (int h = 0; h < 2; ++h)
#pragma unroll
                for (int i = 0; i < 2; ++i) nvoA[h][i] = voA[h][i]; } }
#pragma nounroll
        for (int t = 0; t < nt; t += 2) {
            const bool last = (t == nt - 2);
            const char* a1 = cA + (size_t)(t + 1) * kstep;
            const char* a2 = last ? nA : cA + (size_t)(t + 2) * kstep; const char* b2 = last ? nB : cB + (size_t)(t + 2) * kstep;
            const char* a3 = a2 + kstep; const char* b3 = b2 + kstep;
            if constexpr (GATHER) asm volatile("" : "+v"(voA[0][0]), "+v"(voA[0][1]), "+v"(voA[1][0]), "+v"(voA[1][1]));
            PG8_LDB(B0, 0, 0); PG8_LDB(B1, 0, 1); PG8_SCHED; PG8_LDA(At, 0, 0); PG8_STAGE(PG8_SA(1, 1), a1, voA[1]);
            PG8_WAIT_V(8); PG8_WAIT_L(0); PG8_BAR; PG8_MMA(0, 0, At, B0); PG8_MMA(0, 1, At, B1); PG8_BAR; PG8_SCHED;
            if constexpr (GATHER) { if (last) {
#pragma unroll
                for (int h = 0; h < 2; ++h)
#pragma unroll
                    for (int i = 0; i < 2; ++i) voA[h][i] = nvoA[h][i];
                asm volatile("" : "+v"(voA[0][0]), "+v"(voA[0][1]), "+v"(voA[1][0]), "+v"(voA[1][1])); } }
            PG8_LDA(At, 0, 1); PG8_STAGE(PG8_SB(0, 0), b2, voffB); PG8_STAGE(PG8_SB(0, 1), b2 + hstepB, voffB); PG8_STAGE(PG8_SA(0, 0), a2, voA[0]);
            PG8_WAIT_V(8); PG8_WAIT_L(0); PG8_BAR; PG8_MMA(1, 0, At, B0); PG8_MMA(1, 1, At, B1); PG8_BAR; PG8_SCHED;
            PG8_LDB(B0, 1, 0); PG8_LDB(B1, 1, 1); PG8_SCHED; PG8_LDA(At, 1, 0); PG8_STAGE(PG8_SA(0, 1), a2, voA[1]);
            PG8_WAIT_V(8); PG8_WAIT_L(0); PG8_BAR; PG8_MMA(0, 0, At, B0); PG8_MMA(0, 1, At, B1); PG8_BAR; PG8_SCHED;
            PG8_LDA(At, 1, 1); PG8_STAGE(PG8_SB(1, 0), b3, voffB); PG8_STAGE(PG8_SB(1, 1), b3 + hstepB, voffB); PG8_STAGE(PG8_SA(1, 0), a3, voA[0]);
            PG8_WAIT_V(8); PG8_WAIT_L(0); PG8_BAR; PG8_MMA(1, 0, At, B0); PG8_MMA(1, 1, At, B1); PG8_BAR; PG8_SCHED;
        }
        if constexpr (ALIGN_EPI) { if (wr == 0) PG8_BAR; }
        if constexpr (FP8) asm volatile("s_nop 15\n\ts_nop 15\n\ts_nop 7" ::: "memory");
        E(acc, cur, wr, wc, fr, fq);
        if (!has_next) break;
#pragma unroll
        for (int a = 0; a < 2; ++a)
#pragma unroll
            for (int b = 0; b < 2; ++b)
#pragma unroll
                for (int m = 0; m < 4; ++m)
#pragma unroll
                    for (int n = 0; n < 2; ++n) acc[a][b][m][n] = (f32x4){0.f, 0.f, 0.f, 0.f};
        cur = nxt; cA = nA; cB = nB; ++ui;
        if constexpr (ALIGN_EPI) { if (wr == 1) PG8_BAR; }
    }
    PG8_WAIT_V(0);
    if constexpr (!ALIGN_EPI) { if (wr == 0) PG8_BAR; }
    PG8_BAR;
#undef PG8_SA
#undef PG8_SB
#undef PG8_STAGE
#undef PG8_LDA
#undef PG8_LDB
#undef PG8_MMA
#undef PG8_CAT
#undef PG8_WAIT_V
#undef PG8_WAIT_L
#undef PG8_BAR
#undef PG8_SCHED
#undef PG8_GIDX
}
}
namespace attn_body {
using bf16=__hip_bfloat16;
using bf16x8=__attribute__((ext_vector_type(8)))short;
using s16x4=__attribute__((ext_vector_type(4)))short;
using f32x16=__attribute__((ext_vector_type(16)))float;
using u32x4=__attribute__((ext_vector_type(4)))unsigned;
constexpr int SEQ=4096,D=64,PQ=2560,PO=1024;
constexpr int NW=8,QBLK=32,QB=QBLK*NW,KVBLK=64,NQB=SEQ/QB;
constexpr int ATTN_UNIT_ROWS=QB;
__device__ __forceinline__ int crow(int r,int hi){return (r&3)+8*(r>>2)+4*hi;}
#define SBAR() __builtin_amdgcn_sched_barrier(0)
__device__ __forceinline__ void cmask(f32x16&p0,f32x16&p1,int jb,int qrel,int hi){
  const float NEG=-INFINITY; int kb=64*jb+4*hi;
  #pragma unroll
  for(int r=0;r<16;++r){int kv=kb+(r&3)+8*(r>>2); if(kv>qrel)p0[r]=NEG; if(kv+32>qrel)p1[r]=NEG;}
}

constexpr int NSLOT=3, SLOTB=8192;
constexpr int LDS_K=0, LDS_V=NSLOT*SLOTB, LDS_WS=2*NSLOT*SLOTB, LDS_OST=LDS_WS+NW*64*4, LDS_BYTES=LDS_OST+NW*4096;
constexpr float C2=0.125f*1.4426950408889634f;
__device__ __forceinline__ void glds16(const void*gsrc,unsigned lds_dst){unsigned keep;
  asm volatile("s_mov_b32 %0, m0\n\ts_mov_b32 m0, %2\n\ts_nop 0\n\tglobal_load_lds_dwordx4 %1, off\n\ts_mov_b32 m0, %0":"=&s"(keep):"v"(gsrc),"s"(lds_dst):"memory");}
__device__ __forceinline__ float max3f(float a,float b,float c){float r;asm("v_max3_f32 %0, %1, %2, %3":"=v"(r):"v"(a),"v"(b),"v"(c));return r;}
__device__ __forceinline__ float max2f(float a,float b){float r;asm("v_max_f32_e32 %0, %1, %2":"=v"(r):"v"(a),"v"(b));return r;}
__device__ __forceinline__ float fadd_s(float a,float b){float r;asm("v_add_f32_e32 %0, %1, %2":"=v"(r):"v"(a),"v"(b));return r;}
__device__ __forceinline__ float fsub_s(float a,float b){float r;asm("v_sub_f32_e32 %0, %1, %2":"=v"(r):"v"(a),"v"(b));return r;}
typedef float f32x2_t __attribute__((ext_vector_type(2))); typedef __bf16 bf16x2_t __attribute__((ext_vector_type(2)));
__device__ __forceinline__ unsigned cvtpk_s(float lo,float hi){f32x2_t v={lo,hi};bf16x2_t b=__builtin_convertvector(v,bf16x2_t);return __builtin_bit_cast(unsigned,b);}
#define WAIT_BAR(N) asm volatile("s_waitcnt vmcnt(" #N ") lgkmcnt(0)\n\ts_barrier":::"memory")

__device__ __forceinline__ void qkt(f32x16&p0,f32x16&p1,const char*Kslot,const bf16x8*qr,int r32,int hi){ const f32x16 negm=f32x16{};
  const char*kb=Kslot+hi*1024+r32*16;
  #pragma unroll
  for(int d0=0;d0<4;++d0){
    const bf16x8 b0=*reinterpret_cast<const bf16x8*>(kb+d0*2048);
    const bf16x8 b1=*reinterpret_cast<const bf16x8*>(kb+d0*2048+512);
    if(d0==0){p0=__builtin_amdgcn_mfma_f32_32x32x16_bf16(b0,qr[0],negm,0,0,0);p1=__builtin_amdgcn_mfma_f32_32x32x16_bf16(b1,qr[0],negm,0,0,0);}
    else{p0=__builtin_amdgcn_mfma_f32_32x32x16_bf16(b0,qr[d0],p0,0,0,0);p1=__builtin_amdgcn_mfma_f32_32x32x16_bf16(b1,qr[d0],p1,0,0,0);}}
}
typedef __attribute__((address_space(3))) const char* lds_cptr;
typedef short v4i16_t __attribute__((ext_vector_type(4)));
__device__ __forceinline__ void kload8(bf16x8*kf,lds_cptr kp){
  kf[0]=*(const __attribute__((address_space(3))) bf16x8*)(kp);      kf[1]=*(const __attribute__((address_space(3))) bf16x8*)(kp+512);
  kf[2]=*(const __attribute__((address_space(3))) bf16x8*)(kp+2048); kf[3]=*(const __attribute__((address_space(3))) bf16x8*)(kp+2560);
  kf[4]=*(const __attribute__((address_space(3))) bf16x8*)(kp+4096); kf[5]=*(const __attribute__((address_space(3))) bf16x8*)(kp+4608);
  kf[6]=*(const __attribute__((address_space(3))) bf16x8*)(kp+6144); kf[7]=*(const __attribute__((address_space(3))) bf16x8*)(kp+6656);
}
__device__ __forceinline__ void kload2(bf16x8*kf,lds_cptr kp,int j){ kf[2*j]=*(const __attribute__((address_space(3))) bf16x8*)(kp+j*2048); kf[2*j+1]=*(const __attribute__((address_space(3))) bf16x8*)(kp+j*2048+512); }
__device__ __forceinline__ s16x4 vtr(lds_cptr p){ return __builtin_bit_cast(s16x4,__builtin_amdgcn_ds_read_tr16_b64_v4i16((__attribute__((address_space(3))) v4i16_t*)p)); }
__device__ __forceinline__ float rowmax(const f32x16&p0,const f32x16&p1){
  float a=max3f(p0[0],p0[1],p1[0]),b=max3f(p0[2],p0[3],p1[1]);a=max3f(a,p1[2],p1[3]);
  #pragma unroll
  for(int r=4;r<16;r+=4){a=max3f(a,p0[r],p0[r+1]);b=max3f(b,p0[r+2],p0[r+3]);a=max3f(a,p1[r],p1[r+1]);b=max3f(b,p1[r+2],p1[r+3]);}
  const float m=max2f(a,b);
  auto rr=__builtin_amdgcn_permlane32_swap(__float_as_uint(m),__float_as_uint(m),false,false);
  return max2f(__uint_as_float(rr[0]),__uint_as_float(rr[1]));
}
__device__ __forceinline__ void pv(f32x16*o,int vb,bf16x8 pa0,bf16x8 pa1,bf16x8 pa2,bf16x8 pa3){
  #pragma unroll
  for(int d0=0;d0<2;++d0){s16x4 lo[4],hi[4];
    #pragma unroll
    for(int ks=0;ks<4;++ks){
      asm volatile("ds_read_b64_tr_b16 %0,%1 offset:%c2":"=&v"(lo[ks]):"v"(vb),"i"(d0*4096+ks*1024):"memory");
      asm volatile("ds_read_b64_tr_b16 %0,%1 offset:%c2":"=&v"(hi[ks]):"v"(vb),"i"(d0*4096+ks*1024+512):"memory");}
    asm volatile("s_waitcnt lgkmcnt(0)":::"memory");SBAR();
    #define PK(k) (bf16x8){lo[k][0],lo[k][1],lo[k][2],lo[k][3],hi[k][0],hi[k][1],hi[k][2],hi[k][3]}
    o[d0]=__builtin_amdgcn_mfma_f32_32x32x16_bf16(pa0,PK(0),o[d0],0,0,0);
    o[d0]=__builtin_amdgcn_mfma_f32_32x32x16_bf16(pa1,PK(1),o[d0],0,0,0);
    o[d0]=__builtin_amdgcn_mfma_f32_32x32x16_bf16(pa2,PK(2),o[d0],0,0,0);
    o[d0]=__builtin_amdgcn_mfma_f32_32x32x16_bf16(pa3,PK(3),o[d0],0,0,0);
    #undef PK
  }
}

#ifndef ATTN_STORE16
#define ATTN_STORE16(p,v) (*(u32x4*)(p)=(v))
#endif
template<int THRL> __device__ __forceinline__ void attn_unit(int b,int qb,const bf16*Q,const bf16*__restrict__ K,const bf16*__restrict__ V,bf16*O,char*shm){
  const int tid=threadIdx.x,lane=tid&63,r32=lane&31,hi=lane>>5; const int wid=__builtin_amdgcn_readfirstlane(tid>>6);
  const long rowbase=(long)b*SEQ; const int q0=qb*QB;
  const bf16*Qw=Q+(rowbase+q0+wid*QBLK)*PQ;
  const bf16*Kh=K+rowbase*PQ,*Vh=V+rowbase*PQ;
  const unsigned lds0=(unsigned)(uintptr_t)shm;
  float*wsf=(float*)(shm+LDS_WS)+wid*64;
  const bf16*ksrc=Kh+(long)lane*PQ+wid*8;
  const bf16*vsrc=Vh+(long)(16*(wid&3)+(lane>>2))*PQ+(wid>>2)*32+(lane&3)*8;
  const unsigned kdst=lds0+LDS_K+wid*1024, vdst=lds0+LDS_V+wid*1024;
  #define DMA_K(t,slot) glds16(ksrc+(long)(t)*KVBLK*PQ,(unsigned)__builtin_amdgcn_readfirstlane(kdst+(slot)))
  #define DMA_V(t,slot) glds16(vsrc+(long)(t)*KVBLK*PQ,(unsigned)__builtin_amdgcn_readfirstlane(vdst+(slot)))
  const int vb0=(int)(lds0+LDS_V)+((lane>>4)&1)*32+(lane&3)*8+(4*hi+((lane&15)>>2))*64;
  const char*Kbase=shm+LDS_K; bf16x8 kf[8];
  const lds_cptr shm3=(lds_cptr)shm; const lds_cptr kp0=shm3+LDS_K+hi*1024+r32*16; const lds_cptr vp0=shm3+LDS_V+((lane>>4)&1)*32+(lane&3)*8+(4*hi+((lane&15)>>2))*64;
  const int NT=(q0+QB)/KVBLK;
  DMA_K(0,0);DMA_V(0,0);DMA_K(1,SLOTB);
  bf16x8 qr[4];
  #pragma unroll
  for(int d0=0;d0<4;++d0)qr[d0]=*reinterpret_cast<const bf16x8*>(&Qw[(long)r32*PQ+d0*16+hi*8]);
  float mhat=0.f,l_reg=0.f;f32x16 o[2];o[0]=f32x16{};o[1]=f32x16{};
  const int qrel=wid*QBLK+r32;
  #define CMASK(P0,P1,t) do{int jb_=(t)-(NT-4); if(jb_>=0)cmask(P0,P1,jb_,qrel,hi);}while(0)
  bool resc=false;
  #define START(P0,P1) do{ const float rm=rowmax(P0,P1); resc=false; \
    { const float dl=rm; mhat=fadd_s(mhat,dl); \
      _Pragma("unroll") for(int r=0;r<16;++r){P0[r]=fsub_s(P0[r],dl);P1[r]=fsub_s(P1[r],dl);} \
      } \
    _Pragma("unroll") for(int r=0;r<16;++r)P0[r]=__builtin_amdgcn_exp2f(P0[r]); }while(0)
  #define RESC() do{ if(resc){ asm volatile("s_waitcnt lgkmcnt(0)":::"memory"); \
      _Pragma("unroll") for(int d_=0;d_<2;++d_) _Pragma("unroll") for(int r=0;r<16;++r)o[d_][r]*=wsf[crow(r,hi)]; } }while(0)
  f32x16 pA0,pA1,pB0,pB1;
  int sl_prev=0,sl_cur=0,sl_next=SLOTB;
  #define ROT() do{sl_prev=sl_cur;sl_cur=sl_next;sl_next=(sl_next==(NSLOT-1)*SLOTB)?0:sl_next+SLOTB;}while(0)
  DMA_K(2,2*SLOTB);
  WAIT_BAR(3);
  qkt(pA0,pA1,Kbase,qr,r32,hi);asm volatile("s_nop 15\n\ts_nop 7":"+v"(pA0),"+v"(pA1));CMASK(pA0,pA1,0);
  START(pA0,pA1);
  _Pragma("unroll") for(int r=0;r<16;++r)pA1[r]=__builtin_amdgcn_exp2f(pA1[r]);
  WAIT_BAR(0);
  DMA_K(3,0);DMA_V(1,SLOTB);
  ROT();
  kload8(kf,kp0+sl_cur);
  WAIT_BAR(2);
  s16x4 vlo[8],vhi[8]; u32x4 pw0,pw1,pw2,pw3;
  #define PKW(P,B) cvtpk_s(P[B],P[B+1])
  #define PAF(k) __builtin_bit_cast(bf16x8,pw##k)
  #define VFR(i) (bf16x8){vlo[i][0],vlo[i][1],vlo[i][2],vlo[i][3],vhi[i][0],vhi[i][1],vhi[i][2],vhi[i][3]}
  #define PIN(x) asm volatile("":"+v"(x))
  #define MX3(a,b,c) __builtin_fmaxf(__builtin_fmaxf((a),(b)),(c))
  #define GAPA(MF,A0,A1,A2,A3,W0,W1,PW) do{ MF; sacc+=A0; sacc+=A1; sacc+=A2; sacc+=A3; PIN(sacc); W0; W1; PIN(PW); SBAR(); }while(0)
  #define EX(v) __builtin_amdgcn_exp2f(v)
  #define GAPB(MF,X,B) do{ MF; X[B]=EX(X[B]-mhat); X[B+1]=EX(X[B+1]-mhat); X[B+2]=EX(X[B+2]-mhat); X[B+3]=EX(X[B+3]-mhat); PIN(X); SBAR(); }while(0)
  #define VRD(i) do{ vlo[i]=vtr(vp_+(((i)>>2)*4096+((i)&3)*1024)); vhi[i]=vtr(vp_+(((i)>>2)*4096+((i)&3)*1024+512)); }while(0)
  #define KRD(G,j) do{ if(G){ kload2(kf,kp0+sl_next,j); SBAR(); } }while(0)
  #define STEP(C0,C1,P0,P1,t,GK,GV,GL) do{ SBAR(); \
    const lds_cptr vp_=vp0+sl_prev; \
    VRD(0); SBAR(); float sacc=(P0[0]+P0[1]); \
    GAPA(C0=__builtin_amdgcn_mfma_f32_32x32x16_bf16(kf[0],qr[0],f32x16{},0,0,0), P0[2],P0[3],P0[4],P0[5],     pw0[0]=PKW(P0,0), pw0[1]=PKW(P0,2), pw0); \
    VRD(4); SBAR(); GAPA(C1=__builtin_amdgcn_mfma_f32_32x32x16_bf16(kf[1],qr[0],f32x16{},0,0,0), P0[6],P0[7],P0[8],P0[9],     pw0[2]=PKW(P0,4), pw0[3]=PKW(P0,6), pw0); \
    VRD(1); SBAR(); GAPA(C0=__builtin_amdgcn_mfma_f32_32x32x16_bf16(kf[2],qr[1],C0,0,0,0),   P0[10],P0[11],P0[12],P0[13], pw1[0]=PKW(P0,8), pw1[1]=PKW(P0,10), pw1); \
    VRD(5); SBAR(); GAPA(C1=__builtin_amdgcn_mfma_f32_32x32x16_bf16(kf[3],qr[1],C1,0,0,0),   P0[14],P0[15],P1[0],P1[1],   pw1[2]=PKW(P0,12),pw1[3]=PKW(P0,14), pw1); \
    VRD(2); SBAR(); GAPA(C0=__builtin_amdgcn_mfma_f32_32x32x16_bf16(kf[4],qr[2],C0,0,0,0),   P1[2],P1[3],P1[4],P1[5],     pw2[0]=PKW(P1,0), pw2[1]=PKW(P1,2), pw2); \
    VRD(6); SBAR(); GAPA(C1=__builtin_amdgcn_mfma_f32_32x32x16_bf16(kf[5],qr[2],C1,0,0,0),   P1[6],P1[7],P1[8],P1[9],     pw2[2]=PKW(P1,4), pw2[3]=PKW(P1,6), pw2); \
    VRD(3); SBAR(); GAPA(C0=__builtin_amdgcn_mfma_f32_32x32x16_bf16(kf[6],qr[3],C0,0,0,0),   P1[10],P1[11],P1[12],P1[13], pw3[0]=PKW(P1,8), pw3[1]=PKW(P1,10), pw3); \
    VRD(7); SBAR(); GAPA(C1=__builtin_amdgcn_mfma_f32_32x32x16_bf16(kf[7],qr[3],C1,0,0,0),   P1[14],P1[15],0.f,0.f,       pw3[2]=PKW(P1,12),pw3[3]=PKW(P1,14), pw3); \
    l_reg+=sacc; \
    if(GK){DMA_K((t)+3,sl_cur);} if(GV){DMA_V((t)+1,sl_next);} \
    CMASK(C0,C1,t); \
    { float a=MX3(C0[0],C0[1],C1[0]),b=MX3(C0[2],C0[3],C1[1]); a=MX3(a,C1[2],C1[3]); \
      _Pragma("unroll") for(int r=4;r<16;r+=4){a=MX3(a,C0[r],C0[r+1]);b=MX3(b,C0[r+2],C0[r+3]);a=MX3(a,C1[r],C1[r+1]);b=MX3(b,C1[r+2],C1[r+3]);} \
      float rm=__builtin_fmaxf(a,b); { auto rr=__builtin_amdgcn_permlane32_swap(__float_as_uint(rm),__float_as_uint(rm),false,false); rm=__builtin_fmaxf(__uint_as_float(rr[0]),__uint_as_float(rr[1])); } \
      resc=false; rm-=mhat; \
      if(__builtin_expect(__any(rm>(float)THRL),0)){ const float dl=__builtin_fmaxf(rm,0.f); mhat+=dl; \
        const float f=__builtin_amdgcn_exp2f(-dl); l_reg*=f; if(hi==0)wsf[r32]=f; resc=true; } } \
    SBAR(); \
    GAPB(o[0]=__builtin_amdgcn_mfma_f32_32x32x16_bf16(PAF(0),VFR(0),o[0],0,0,0), C0,0); \
    GAPB(o[1]=__builtin_amdgcn_mfma_f32_32x32x16_bf16(PAF(0),VFR(4),o[1],0,0,0), C0,4); \
    KRD(GL,0); GAPB(o[0]=__builtin_amdgcn_mfma_f32_32x32x16_bf16(PAF(1),VFR(1),o[0],0,0,0), C0,8); \
    KRD(GL,1); GAPB(o[1]=__builtin_amdgcn_mfma_f32_32x32x16_bf16(PAF(1),VFR(5),o[1],0,0,0), C0,12); \
    KRD(GL,2); GAPB(o[0]=__builtin_amdgcn_mfma_f32_32x32x16_bf16(PAF(2),VFR(2),o[0],0,0,0), C1,0); \
    KRD(GL,3); GAPB(o[1]=__builtin_amdgcn_mfma_f32_32x32x16_bf16(PAF(2),VFR(6),o[1],0,0,0), C1,4); \
    GAPB(o[0]=__builtin_amdgcn_mfma_f32_32x32x16_bf16(PAF(3),VFR(3),o[0],0,0,0), C1,8); \
    GAPB(o[1]=__builtin_amdgcn_mfma_f32_32x32x16_bf16(PAF(3),VFR(7),o[1],0,0,0), C1,12); \
    }while(0)
  int t=1;
  #undef CMASK
  #define CMASK(P0,P1,t) do{}while(0)
  for(;t+5<NT;t+=2){
    STEP(pB0,pB1,pA0,pA1,t,true,true,true);     WAIT_BAR(2); RESC(); ROT();
    STEP(pA0,pA1,pB0,pB1,t+1,true,true,true);   WAIT_BAR(2); RESC(); ROT();
  }
  #undef CMASK
  #define CMASK(P0,P1,t) do{int jb_=(t)-(NT-4); if(jb_>=0)cmask(P0,P1,jb_,qrel,hi);}while(0)
  #define ENDW(tt) do{ if((tt)+3<NT){WAIT_BAR(2);} else if((tt)+2<NT){WAIT_BAR(1);} else {WAIT_BAR(0);} }while(0)
  for(;t+1<NT;t+=2){
    STEP(pB0,pB1,pA0,pA1,t,(t+3<NT),(t+1<NT),(t+1<NT));       ENDW(t);   RESC(); ROT();
    STEP(pA0,pA1,pB0,pB1,t+1,(t+4<NT),(t+2<NT),(t+2<NT));     ENDW(t+1); RESC(); ROT();
  }
  STEP(pB0,pB1,pA0,pA1,NT-1,false,false,false); RESC();
  { float sacc=pB0[0]+pB0[1]; _Pragma("unroll") for(int r=2;r<16;++r)sacc+=pB0[r]; _Pragma("unroll") for(int r=0;r<16;++r)sacc+=pB1[r]; l_reg+=sacc;
    pw0=(u32x4){PKW(pB0,0),PKW(pB0,2),PKW(pB0,4),PKW(pB0,6)};pw1=(u32x4){PKW(pB0,8),PKW(pB0,10),PKW(pB0,12),PKW(pB0,14)};pw2=(u32x4){PKW(pB1,0),PKW(pB1,2),PKW(pB1,4),PKW(pB1,6)};pw3=(u32x4){PKW(pB1,8),PKW(pB1,10),PKW(pB1,12),PKW(pB1,14)};
    SBAR(); pv(o,vb0+sl_cur,PAF(0),PAF(1),PAF(2),PAF(3)); }
  #undef PKW
  #undef PAF
  #undef VFR
  #undef PIN
  #undef MX3
  #undef GAPA
  #undef GAPB
  #undef EX
  #undef VRD
  #undef KRD
  #undef STEP
  #undef ENDW
  {auto rr=__builtin_amdgcn_permlane32_swap(__float_as_uint(l_reg),__float_as_uint(l_reg),false,false);l_reg=__uint_as_float(rr[0])+__uint_as_float(rr[1]);}
  if(hi==0)wsf[32+r32]=l_reg;asm volatile("s_waitcnt lgkmcnt(0)":::"memory");
  float rli[16];
  #pragma unroll
  for(int r=0;r<16;++r)rli[r]=__builtin_amdgcn_rcpf(wsf[32+crow(r,hi)]);
  bf16*Ow=O+(rowbase+q0+wid*QBLK)*PO;
  { bf16*stg=(bf16*)(shm+LDS_OST)+wid*2048;
    #pragma unroll
    for(int r=0;r<16;++r){const int orow=crow(r,hi);
      #pragma unroll
      for(int d0=0;d0<2;++d0)stg[orow*64+d0*32+r32]=__float2bfloat16(o[d0][r]*rli[r]);}
    asm volatile("s_waitcnt lgkmcnt(0)":::"memory");
    #pragma unroll
    for(int i=0;i<4;++i){const int row=i*8+(lane>>3),ch=lane&7; const u32x4 v=*(const u32x4*)(stg+row*64+ch*8); ATTN_STORE16(Ow+(long)row*PO+ch*8,v);} }
  asm volatile("s_waitcnt lgkmcnt(0)\n\ts_barrier":::"memory");
  #undef DMA_K
  #undef DMA_V
  #undef CMASK
  #undef START
  #undef RESC
  #undef ROT
}
constexpr int ATTN_LDS_BYTES=LDS_BYTES;
constexpr int A2_K=0, A2_V=NSLOT*8192, A2_WS=A2_V+NSLOT*16384, A2_ST=A2_WS+NW*64*4, A2_BYTES=A2_ST+NW*8192;
#define A2_WAITBAR(N) asm volatile("s_waitcnt vmcnt(" #N ") lgkmcnt(0)\n\ts_barrier":::"memory")
template<int THRL> __device__ __forceinline__ void attn_unit2(int b,int qb,const bf16*Q,const bf16*__restrict__ K,const bf16*__restrict__ V,bf16*O,char*shm,int mode,float lam,const float*__restrict__ subg){
  const int tid=threadIdx.x,lane=tid&63,r32=lane&31,hi=lane>>5; const int wid=__builtin_amdgcn_readfirstlane(tid>>6);
  const long rowbase=(long)b*SEQ; const int q0=qb*QB;
  const bf16*Qw=Q+(rowbase+q0+wid*QBLK)*PQ;
  const bf16*Kh=K+rowbase*PQ,*Vh=V+rowbase*PQ;
  const unsigned lds0=(unsigned)(uintptr_t)shm;
  float*wsf=(float*)(shm+A2_WS)+wid*64;
  const bf16*ksrc=Kh+(long)lane*PQ+wid*8;
  const bf16*vsrc=Vh+(long)(16*(wid&3)+(lane>>2))*PQ+(wid>>2)*32+(lane&3)*8;
  const unsigned kdst=lds0+A2_K+wid*1024, vdst=lds0+A2_V+wid*1024;
  #define A2_DMA(t,sl) do{ glds16(ksrc+(long)(t)*KVBLK*PQ,(unsigned)__builtin_amdgcn_readfirstlane(kdst+(sl)*8192)); \
      glds16(vsrc+(long)(t)*KVBLK*PQ,(unsigned)__builtin_amdgcn_readfirstlane(vdst+(sl)*16384)); glds16(vsrc+(long)(t)*KVBLK*PQ+64,(unsigned)__builtin_amdgcn_readfirstlane(vdst+(sl)*16384+8192)); }while(0)
  const lds_cptr shm3=(lds_cptr)shm;
  const lds_cptr kp0=shm3+A2_K+hi*1024+r32*16;
  const lds_cptr vp0=shm3+A2_V+((lane>>4)&1)*32+(lane&3)*8+(4*hi+((lane&15)>>2))*64;
  const int NT=(q0+QB)/KVBLK;
  bf16x8 qr[4];
  #pragma unroll
  for(int d0=0;d0<4;++d0)qr[d0]=*reinterpret_cast<const bf16x8*>(&Qw[(long)r32*PQ+d0*16+hi*8]);
  A2_DMA(0,0); A2_DMA(1,1);
  float mhat=0.f,l_reg=0.f; f32x16 o[4]; o[0]=f32x16{}; o[1]=f32x16{}; o[2]=f32x16{}; o[3]=f32x16{};
  bool first=true; int sl=0;
  const int qw0=q0+wid*QBLK;
  for(int t=0;t<NT;++t){
    if(t+1<NT){A2_WAITBAR(3);}else{A2_WAITBAR(0);}
    if(t+2<NT){ const int s2=(sl==0)?2:sl-1; A2_DMA(t+2,s2); }
    {
      const int kv0=64*t;
      const bool two=!(kv0+32>qw0+31);
      f32x16 S0=f32x16{},S1=f32x16{};
      #pragma unroll
      for(int d0=0;d0<4;++d0){ const bf16x8 kf=*(const __attribute__((address_space(3))) bf16x8*)(kp0+sl*8192+d0*2048); S0=__builtin_amdgcn_mfma_f32_32x32x16_bf16(kf,qr[d0],S0,0,0,0); }
      if(two){
        #pragma unroll
        for(int d0=0;d0<4;++d0){ const bf16x8 kf=*(const __attribute__((address_space(3))) bf16x8*)(kp0+sl*8192+d0*2048+512); S1=__builtin_amdgcn_mfma_f32_32x32x16_bf16(kf,qr[d0],S1,0,0,0); } }
      if(kv0+63>qw0){ const int qpos=qw0+r32;
        #pragma unroll
        for(int r=0;r<16;++r){ const int kv=kv0+crow(r,hi); if(kv>qpos)S0[r]=-INFINITY; if(kv+32>qpos)S1[r]=-INFINITY; } }
      float rm=S0[0];
      #pragma unroll
      for(int r=1;r<16;++r)rm=__builtin_fmaxf(rm,S0[r]);
      if(two){
        #pragma unroll
        for(int r=0;r<16;++r)rm=__builtin_fmaxf(rm,S1[r]); }
      { auto rr=__builtin_amdgcn_permlane32_swap(__float_as_uint(rm),__float_as_uint(rm),false,false); rm=__builtin_fmaxf(__uint_as_float(rr[0]),__uint_as_float(rr[1])); }
      if(first){ mhat=rm; first=false; }
      else if(__any(rm-mhat>(float)THRL)){ const float dl=__builtin_fmaxf(rm-mhat,0.f); mhat+=dl; const float f=__builtin_amdgcn_exp2f(-dl); l_reg*=f;
        if(hi==0)wsf[r32]=f; asm volatile("s_waitcnt lgkmcnt(0)":::"memory");
        #pragma unroll
        for(int r=0;r<16;++r){ const float fr_=wsf[crow(r,hi)]; o[0][r]*=fr_; o[1][r]*=fr_; o[2][r]*=fr_; o[3][r]*=fr_; }
        asm volatile("s_waitcnt lgkmcnt(0)":::"memory"); }
      float ps=0.f;
      #pragma unroll
      for(int r=0;r<16;++r){ S0[r]=__builtin_amdgcn_exp2f(S0[r]-mhat); ps+=S0[r]; }
      u32x4 pw0,pw1,pw2,pw3;
      pw0=(u32x4){cvtpk_s(S0[0],S0[1]),cvtpk_s(S0[2],S0[3]),cvtpk_s(S0[4],S0[5]),cvtpk_s(S0[6],S0[7])};
      pw1=(u32x4){cvtpk_s(S0[8],S0[9]),cvtpk_s(S0[10],S0[11]),cvtpk_s(S0[12],S0[13]),cvtpk_s(S0[14],S0[15])};
      const lds_cptr vp=vp0+sl*16384;
      if(two){
        #pragma unroll
        for(int r=0;r<16;++r){ S1[r]=__builtin_amdgcn_exp2f(S1[r]-mhat); ps+=S1[r]; }
        pw2=(u32x4){cvtpk_s(S1[0],S1[1]),cvtpk_s(S1[2],S1[3]),cvtpk_s(S1[4],S1[5]),cvtpk_s(S1[6],S1[7])};
        pw3=(u32x4){cvtpk_s(S1[8],S1[9]),cvtpk_s(S1[10],S1[11]),cvtpk_s(S1[12],S1[13]),cvtpk_s(S1[14],S1[15])};
      }
      l_reg+=ps;
      __builtin_amdgcn_s_setprio(1);
      #pragma unroll
      for(int d0=0;d0<4;++d0){
        const s16x4 l0=vtr(vp+d0*4096), h0=vtr(vp+d0*4096+512), l1=vtr(vp+d0*4096+1024), h1=vtr(vp+d0*4096+1536);
        o[d0]=__builtin_amdgcn_mfma_f32_32x32x16_bf16(__builtin_bit_cast(bf16x8,pw0),(bf16x8){l0[0],l0[1],l0[2],l0[3],h0[0],h0[1],h0[2],h0[3]},o[d0],0,0,0);
        o[d0]=__builtin_amdgcn_mfma_f32_32x32x16_bf16(__builtin_bit_cast(bf16x8,pw1),(bf16x8){l1[0],l1[1],l1[2],l1[3],h1[0],h1[1],h1[2],h1[3]},o[d0],0,0,0);
      }
      if(two){
        #pragma unroll
        for(int d0=0;d0<4;++d0){
          const s16x4 l0=vtr(vp+d0*4096+2048), h0=vtr(vp+d0*4096+2560), l1=vtr(vp+d0*4096+3072), h1=vtr(vp+d0*4096+3584);
          o[d0]=__builtin_amdgcn_mfma_f32_32x32x16_bf16(__builtin_bit_cast(bf16x8,pw2),(bf16x8){l0[0],l0[1],l0[2],l0[3],h0[0],h0[1],h0[2],h0[3]},o[d0],0,0,0);
          o[d0]=__builtin_amdgcn_mfma_f32_32x32x16_bf16(__builtin_bit_cast(bf16x8,pw3),(bf16x8){l1[0],l1[1],l1[2],l1[3],h1[0],h1[1],h1[2],h1[3]},o[d0],0,0,0);
        }
      }
      __builtin_amdgcn_s_setprio(0);
    }
    sl=(sl==NSLOT-1)?0:sl+1;
  }
  {auto rr=__builtin_amdgcn_permlane32_swap(__float_as_uint(l_reg),__float_as_uint(l_reg),false,false);l_reg=__uint_as_float(rr[0])+__uint_as_float(rr[1]);}
  if(hi==0)wsf[32+r32]=l_reg; asm volatile("s_waitcnt lgkmcnt(0)":::"memory");
  float rli[16];
  #pragma unroll
  for(int r=0;r<16;++r)rli[r]=__builtin_amdgcn_rcpf(wsf[32+crow(r,hi)]);
  char*st=shm+A2_ST+wid*8192;
  if(mode==0){
    #pragma unroll
    for(int k=0;k<8;++k){ const int d0=k>>1,r0=8*(k&1);
      const u32x4 w={cvtpk_s(o[d0][r0]*rli[r0],o[d0][r0+1]*rli[r0+1]),cvtpk_s(o[d0][r0+2]*rli[r0+2],o[d0][r0+3]*rli[r0+3]),cvtpk_s(o[d0][r0+4]*rli[r0+4],o[d0][r0+5]*rli[r0+5]),cvtpk_s(o[d0][r0+6]*rli[r0+6],o[d0][r0+7]*rli[r0+7])};
      *(u32x4*)(st+k*1024+lane*16)=w; }
  }else{
    const float nl=-lam;
    #pragma unroll
    for(int k=0;k<8;++k){ const int d0=k>>1,r0=8*(k&1); const u32x4 c=*(const u32x4*)(st+k*1024+lane*16);
      #pragma unroll
      for(int j=0;j<4;++j){ const unsigned u=c[j]; const unsigned ulo=u<<16,uhi=u&0xffff0000u;
        o[d0][r0+2*j]=__builtin_fmaf(nl,o[d0][r0+2*j]*rli[r0+2*j],__uint_as_float(ulo));
        o[d0][r0+2*j+1]=__builtin_fmaf(nl,o[d0][r0+2*j+1]*rli[r0+2*j+1],__uint_as_float(uhi)); } }
    asm volatile("s_waitcnt lgkmcnt(0)":::"memory");
    const float g0_=subg[r32],g1_=subg[32+r32],g2_=subg[64+r32],g3_=subg[96+r32];
    bf16*stg=(bf16*)st; bf16*Ow=O+(rowbase+q0+wid*QBLK)*PO;
    #pragma unroll
    for(int r=0;r<16;++r){ float ss=(o[0][r]*o[0][r]+o[1][r]*o[1][r])+(o[2][r]*o[2][r]+o[3][r]*o[3][r]);
      ss+=__shfl_xor(ss,1); ss+=__shfl_xor(ss,2); ss+=__shfl_xor(ss,4); ss+=__shfl_xor(ss,8); ss+=__shfl_xor(ss,16);
      const float rs=0.8f/sqrtf(ss*(1.0f/128.0f)+1e-5f); const int orow=crow(r,hi);
      stg[orow*128+r32]=__float2bfloat16(o[0][r]*rs*g0_); stg[orow*128+32+r32]=__float2bfloat16(o[1][r]*rs*g1_); stg[orow*128+64+r32]=__float2bfloat16(o[2][r]*rs*g2_); stg[orow*128+96+r32]=__float2bfloat16(o[3][r]*rs*g3_); }
    asm volatile("s_waitcnt lgkmcnt(0)":::"memory");
    #pragma unroll
    for(int i=0;i<8;++i){ const int row=i*4+(lane>>4),ch=lane&15; const u32x4 v=*(const u32x4*)(stg+row*128+ch*8); ATTN_STORE16(Ow+(long)row*PO+ch*8,v); }
  }
  asm volatile("s_waitcnt lgkmcnt(0)\n\ts_barrier":::"memory");
  #undef A2_DMA
}
#undef A2_WAITBAR
struct AttnTensors { const bf16* Q; const bf16* K; const bf16* V; bf16* O; float lam; const float* subg; };
struct AttnUnit { int b, hm, vh, qb; };
struct StaticOrder {
  int vcu, G;
  __device__ __forceinline__ explicit StaticOrder(int grid,int v):vcu(v),G(grid){}
  __device__ __forceinline__ bool next(int i,AttnUnit&u)const{ const int vv=vcu+(i>>3)*G; if(vv>=256)return false; const int bh=vv>>3,p=vv&7,j=i&7,combo=j&3;
    u.b=bh>>2; u.hm=2*(bh&3)+(combo>>1); u.vh=combo&1; u.qb=(j<4)?15-p:p; return true; }
  __device__ __forceinline__ void a_ready(const AttnUnit&)const{}
  __device__ __forceinline__ void done(const AttnUnit&)const{}
};
template<class Sched,int THRL=8> __device__ __forceinline__ void attn_phase(char*lds,const AttnTensors&T,const Sched&S){
  AttnUnit u;
  for(int i=0;S.next(i,u);++i){ S.a_ready(u);
    attn_unit<THRL>(u.b,u.qb,T.Q+u.hm*64,T.K+u.hm*64,T.V+(u.hm>>1)*128+u.vh*64,T.O+u.hm*128+u.vh*64,lds); S.done(u); }
}
struct StaticOrder2 {
  int vcu, G;
  __device__ __forceinline__ explicit StaticOrder2(int grid,int v):vcu(v),G(grid){}
  __device__ __forceinline__ bool next(int i,AttnUnit&u)const{ const int vv=vcu+(i>>2)*G; if(vv>=256)return false; const int bh=vv>>3,p=vv&7,j=i&3;
    u.b=bh>>2; u.hm=2*(bh&3)+(j&1); u.vh=0; u.qb=(j<2)?15-p:p; return true; }
};
template<class Sched,int THRL=8> __device__ __forceinline__ void attn_phase2(char*lds,const AttnTensors&T,const Sched&S){
  AttnUnit u;
  for(int i=0;S.next(i,u);++i){ attn_unit2<THRL>(u.b,u.qb,T.Q+u.hm*64,T.K+u.hm*64,T.V+(u.hm>>1)*128,T.O+(u.hm>>1)*128,lds,u.hm&1,T.lam,T.subg); }
}
#undef SBAR
#undef WAIT_BAR
}
#define GAS __attribute__((address_space(1)))
#define LAS __attribute__((address_space(3)))
typedef unsigned short bf16;
typedef unsigned v4u __attribute__((ext_vector_type(4)));
typedef float f32x4 __attribute__((ext_vector_type(4)));
typedef short bf16x8 __attribute__((ext_vector_type(8)));
typedef GAS unsigned gu32;
typedef GAS unsigned long long gu64;
#define RLX_AGENT __ATOMIC_RELAXED, __HIP_MEMORY_SCOPE_AGENT
#define LDS_WAIT() asm volatile("s_waitcnt lgkmcnt(0)" ::: "memory")
#define VM_WAIT() asm volatile("s_waitcnt vmcnt(0)" ::: "memory")
__device__ __forceinline__ unsigned long long rt() { return __builtin_amdgcn_s_memrealtime(); }
__device__ __forceinline__ unsigned f2bf(float f) { unsigned u = __builtin_bit_cast(unsigned, f); return (u + 0x7fffu + ((u >> 16) & 1u)) >> 16; }
__device__ __forceinline__ unsigned pk2(float lo, float hi) { return f2bf(lo) | (f2bf(hi) << 16); }

#define XB_TMO      128
#define XB_XCNT(j)  (256  + 64 * (j))
#define XB_XSUB(j)  (1280 + 64 * (j))
#define XB_XGEN(j)  (2304 + 64 * (j))
#define XB_TOP      3328
#define XB_TOPGEN   3392
#define XCD_BAR_WORDS 3456
#define XB_SPIN_CAP (1u << 22)

__device__ __forceinline__ unsigned xb_ld(unsigned* p)              { return __hip_atomic_load(p, __ATOMIC_RELAXED, __HIP_MEMORY_SCOPE_AGENT); }
__device__ __forceinline__ unsigned xb_add(unsigned* p, unsigned v) { return __hip_atomic_fetch_add(p, v, __ATOMIC_RELAXED, __HIP_MEMORY_SCOPE_AGENT); }
__device__ __forceinline__ unsigned xb_xcc_id() { return (unsigned)__builtin_amdgcn_s_getreg((3 << 11) | 20) & 0xFu; }
#define XB_SPIN(cond, bar) do { unsigned _sp = 0; while (cond) { __builtin_amdgcn_s_sleep(1); \
    if ((++_sp & 255u) == 0u) { if (xb_ld(&(bar)[XB_TMO])) break; if (_sp > XB_SPIN_CAP) { atomicAdd(&(bar)[XB_TMO], 1u); break; } } } } while (0)

struct XcdBarrier {
    unsigned* bar; unsigned x;
    volatile LAS unsigned* st;
};

__device__ __forceinline__ XcdBarrier xcd_barrier_post(unsigned* bar, volatile LAS unsigned* st) {
    XcdBarrier b; b.bar = bar; b.x = xb_xcc_id(); b.st = st;
    if (threadIdx.x == 0) (void)xb_add(&bar[XB_XCNT(b.x)], 1u);
    return b;
}
__device__ __forceinline__ void xcd_barrier_complete(unsigned* bar, unsigned x, unsigned& nloc, unsigned& nx) {
    const unsigned G = gridDim.x * gridDim.y * gridDim.z;
    unsigned sum, cnt, mine, sp = 0u;
    for (;;) {
        sum = 0u; cnt = 0u; mine = 0u;
#pragma unroll
        for (unsigned j = 0; j < 16; ++j) { const unsigned c = xb_ld(&bar[XB_XCNT(j)]); sum += c; cnt += (c > 0u) ? 1u : 0u; mine = (j == x) ? c : mine; }
        if (sum == G) break;
        __builtin_amdgcn_s_sleep(1);
        if ((++sp & 255u) == 0u) { if (xb_ld(&bar[XB_TMO])) break; if (sp > XB_SPIN_CAP) { atomicAdd(&bar[XB_TMO], 1u); break; } }
    }
    nloc = mine > 0u ? mine : 1u; nx = cnt > 0u ? cnt : 1u;
}

__device__ __forceinline__ void xcd_barrier(const XcdBarrier& b) {
    asm volatile("s_waitcnt vmcnt(0)" ::: "memory");
    __syncthreads();
    if (threadIdx.x == 0) {
        unsigned* bar = b.bar;
        __builtin_amdgcn_s_waitcnt(0);
        unsigned nloc = b.st[0], nx = b.st[1];
        if (nloc == 0u) { xcd_barrier_complete(bar, b.x, nloc, nx); b.st[0] = nloc; b.st[1] = nx; }
        const unsigned old = xb_add(&bar[XB_XSUB(b.x)], 1u);
        const unsigned gen = old / nloc;
        if (old + 1u == (gen + 1u) * nloc) {
            __builtin_amdgcn_fence(__ATOMIC_RELEASE, "agent");
            asm volatile("s_waitcnt vmcnt(0)" ::: "memory");
            const unsigned og = xb_add(&bar[XB_TOP], 1u);
            const unsigned tg = og / nx;
            if (og + 1u == (tg + 1u) * nx) xb_add(&bar[XB_TOPGEN], 1u);
            else XB_SPIN(xb_ld(&bar[XB_TOPGEN]) == tg, bar);
            __builtin_amdgcn_fence(__ATOMIC_ACQUIRE, "agent");
            xb_add(&bar[XB_XGEN(b.x)], 1u);
            asm volatile("s_waitcnt vmcnt(0)" ::: "memory");
        } else {
            XB_SPIN(xb_ld(&bar[XB_XGEN(b.x)]) == gen, bar);
            __builtin_amdgcn_fence(__ATOMIC_ACQUIRE, "agent");
            asm volatile("s_waitcnt vmcnt(0)" ::: "memory");
        }
    }
    __syncthreads();
}

constexpr int NWAVES = 8;
constexpr int NTOK = 32768, SEQL = 4096, DMODEL = 1024, INW = 2560, FFND = 2816, NEXP = 8, EDIM = 3584;
constexpr int MAXTILES = 264;
constexpr size_t MiB = 1u << 20;
constexpr size_t WS_CTL = 510 * MiB, CTL_ZERO_BYTES = 2 * MiB;
constexpr size_t WS_WIN = 1 * MiB, WS_WOUT = 6 * MiB, WS_WF1 = 8 * MiB, WS_WF2 = 19 * MiB, WS_WPL = 25 * MiB;
constexpr size_t WS_WM1 = 26 * MiB, WS_WM2 = 82 * MiB;
constexpr size_t WS_TAB = 110 * MiB;
constexpr size_t WS_ROPE = WS_TAB, WS_SSQ1 = WS_TAB + 1 * MiB, WS_SSQ2 = WS_TAB + 3 * MiB, WS_TOPK = WS_TAB + 5 * MiB, WS_CNT = WS_TAB + 5 * MiB + 512 * 1024,
                 WS_STOK = WS_TAB + 6 * MiB, WS_SSLOT = WS_TAB + 6 * MiB + 512 * 1024, WS_SGATE = WS_TAB + 7 * MiB, WS_TINFO = WS_TAB + 7 * MiB + 512 * 1024;
constexpr size_t WS_RGW = WS_TAB + 512 * 1024;
constexpr size_t WS_SUMM = WS_CTL + 1 * MiB;
constexpr size_t WS_SLOTA = 118 * MiB;
constexpr size_t WS_XN = 406 * MiB;
constexpr size_t WS_PROJ = 182 * MiB;
constexpr size_t WS_AR = 342 * MiB;
constexpr size_t WS_XS = WS_TAB + 7 * MiB + 640 * 1024;
constexpr size_t WS_H1B = 150 * MiB;
constexpr size_t WS_HID = 246 * MiB;
constexpr size_t WS_H1Q = 334 * MiB;
constexpr size_t WS_Y = 214 * MiB;
constexpr size_t WS_HIDS = 278 * MiB;
constexpr size_t WS_END = 512 * MiB;
static_assert(WS_HID + (size_t)NTOK * FFND * 2 <= WS_END && WS_HIDS + (size_t)MAXTILES * 256 * EDIM <= WS_CTL && WS_CTL + CTL_ZERO_BYTES <= WS_END && WS_AR + (size_t)NTOK * 1024 * 2 <= WS_END && WS_Y + (size_t)2 * NTOK * 1024 <= WS_HIDS && WS_H1B + (size_t)NTOK * 1024 * 2 <= WS_Y && WS_SLOTA + (size_t)NTOK * 1024 <= WS_H1B && WS_XN + (size_t)NTOK * 1024 * 2 <= WS_END, "d_ws map");
static_assert(WS_WM1 + (size_t)NEXP * 7168 * 1024 <= WS_WM2 && WS_WM2 + (size_t)NEXP * 1024 * EDIM <= WS_TAB, "d_ws weights map");
constexpr int CW_TMO = 0, CW_CODE = 1, CW_BAR = 4096, CW_RGF = 65536;
constexpr int RING_OFF = 0, RING_BYTES = 131072;
constexpr int LDSCTL_OFF = 141312, MISC_OFF = LDSCTL_OFF + 320;
static_assert(LDSCTL_OFF >= RING_BYTES && LDSCTL_OFF >= attn_body::A2_BYTES, "LDS map");
constexpr int LDS_BYTES = 147456;
static_assert(MISC_OFF + 128 <= LDS_BYTES, "LDS map");

__device__ __forceinline__ float wave_sum(float v) {
#pragma unroll
    for (int o = 1; o < 64; o <<= 1) v += __shfl_xor(v, o);
    return v;
}
__device__ __forceinline__ float bf2f(bf16 v) { return __builtin_bit_cast(float, (unsigned)v << 16); }
__device__ __forceinline__ float sigmoidf_(float x) { return 1.0f / (1.0f + __expf(-x)); }
__device__ __forceinline__ float gelu_tanh(float x) { const float z = 0.7978845608028654f * (x + 0.044715f * x * x * x); const float t = 1.0f - 2.0f / (1.0f + __expf(2.0f * z)); return 0.5f * x * (1.0f + t); }

__device__ __forceinline__ void tr_item(const float* W, int N, int k0, int n0, const float* gain, bf16* WT, size_t drow0, int ldk, LAS float* scr, int lane) {
    float v[32];
    const float* wp = W + (size_t)(k0 + (lane >> 5)) * N + n0 + (lane & 31);
#pragma unroll
    for (int i = 0; i < 32; ++i) v[i] = wp[(size_t)(2 * i) * N];
    const int c = lane & 7;
    f32x4 g0 = (f32x4){1.f, 1.f, 1.f, 1.f}, g1 = g0;
    if (gain) { g0 = *(const f32x4*)(gain + k0 + 8 * c); g1 = *(const f32x4*)(gain + k0 + 8 * c + 4); }
#pragma unroll
    for (int i = 0; i < 32; ++i) scr[(2 * i + (lane >> 5)) * 33 + (lane & 31)] = v[i];
    LDS_WAIT(); asm volatile("" ::: "memory");
#pragma unroll
    for (int j = 0; j < 4; ++j) { const int n = (lane >> 3) + 8 * j; const LAS float* s = scr + (8 * c) * 33 + n;
        v4u o; o.x = pk2(s[0 * 33] * g0.x, s[1 * 33] * g0.y); o.y = pk2(s[2 * 33] * g0.z, s[3 * 33] * g0.w); o.z = pk2(s[4 * 33] * g1.x, s[5 * 33] * g1.y); o.w = pk2(s[6 * 33] * g1.z, s[7 * 33] * g1.w);
        *(GAS v4u*)(WT + (drow0 + n) * (size_t)ldk + k0 + 8 * c) = o; }
    LDS_WAIT(); asm volatile("" ::: "memory");
}

__device__ __forceinline__ void tr_item8(const float* W, int N, int k0, int n0, const float* gain, float sc, unsigned char* WT, size_t drow0, int ldk, LAS float* scr, int lane) {
    float v[32];
    const float* wp = W + (size_t)(k0 + (lane >> 5)) * N + n0 + (lane & 31);
#pragma unroll
    for (int i = 0; i < 32; ++i) v[i] = wp[(size_t)(2 * i) * N];
    const int c = lane & 7;
    f32x4 g0 = (f32x4){sc, sc, sc, sc}, g1 = g0;
    if (gain) { g0 = *(const f32x4*)(gain + k0 + 8 * c) * sc; g1 = *(const f32x4*)(gain + k0 + 8 * c + 4) * sc; }
#pragma unroll
    for (int i = 0; i < 32; ++i) scr[(2 * i + (lane >> 5)) * 33 + (lane & 31)] = v[i];
    LDS_WAIT(); asm volatile("" ::: "memory");
#pragma unroll
    for (int j = 0; j < 4; ++j) { const int n = (lane >> 3) + 8 * j; const LAS float* s = scr + (8 * c) * 33 + n;
        pg8::u32x2 o; o.x = pg8::cvt4_fp8(s[0 * 33] * g0.x, s[1 * 33] * g0.y, s[2 * 33] * g0.z, s[3 * 33] * g0.w); o.y = pg8::cvt4_fp8(s[4 * 33] * g1.x, s[5 * 33] * g1.y, s[6 * 33] * g1.z, s[7 * 33] * g1.w);
        *(GAS pg8::u32x2*)(WT + (drow0 + n) * (size_t)ldk + k0 + 8 * c) = o; }
    LDS_WAIT(); asm volatile("" ::: "memory");
}

#ifndef MK_REP
#define MK_REP -1
#endif
struct Args { const float* in[29]; float* out; unsigned char* ws; int ph_lo, ph_hi; };
constexpr int PH_FINAL = 13, PH_END = 14;

__global__ void __launch_bounds__(NWAVES * 64, 2) mk_fwd(Args args) {
    extern __shared__ __attribute__((aligned(16))) unsigned char lds_raw[];
    LAS unsigned char* lds = (LAS unsigned char*)lds_raw;
    volatile LAS unsigned* MISC = (volatile LAS unsigned*)(lds + MISC_OFF);
    const int G = gridDim.x, bid = blockIdx.x;
    const int vcu = (G % 8 == 0) ? (bid % 8) * (G / 8) + bid / 8 : bid;
    typedef const __attribute__((address_space(4))) char* kargp_t;
#define KARG(kp) kargp_t kp = (kargp_t)__builtin_amdgcn_kernarg_segment_ptr(); asm volatile("" : "+s"(kp))
#define KIN(kp, k) (*(const float* const __attribute__((address_space(4)))*)((kp) + 8 * (k)))
#define KOUT(kp) (*(float* const __attribute__((address_space(4)))*)((kp) + 232))
#define KWS(kp) (*(unsigned char* const __attribute__((address_space(4)))*)((kp) + 240))
    gu32* ctl;
    { KARG(kp); ctl = (gu32*)(KWS(kp) + WS_CTL); }
    for (int u = threadIdx.x; u < (LDS_BYTES - LDSCTL_OFF) / 4; u += NWAVES * 64) ((LAS unsigned*)(lds + LDSCTL_OFF))[u] = 0u;
    __syncthreads();
    const int lo = args.ph_lo, hi = args.ph_hi;
    const bool multi = (hi - lo) > 1;
    XcdBarrier bar; bar.bar = (unsigned*)(ctl + CW_BAR); bar.x = 0; bar.st = nullptr;
    if (multi) bar = xcd_barrier_post((unsigned*)(ctl + CW_BAR), MISC + 8);
#ifndef PHMASK
#define PHMASK 0xffffffffu
#endif
#define IN(k) (((PHMASK >> (k)) & 1u) && lo <= (k) && (k) < hi)
#define BOTH(k) (IN(k) && IN((k) == 2 ? 4 : (k) + 1))
#define GRID_BAR() xcd_barrier(bar)
#define PHASE_IDS() int tid_ = threadIdx.x; asm volatile("" : "+v"(tid_)); const int tid = tid_, lane = tid & 63, wave = __builtin_amdgcn_readfirstlane(tid >> 6), gw = vcu * NWAVES + wave, NGW = G * NWAVES; (void)lane; (void)gw; (void)NGW

    if (IN(0)) for (int rep_ = 0; rep_ < 1 + (MK_REP == 0 ? 1 : 0); ++rep_) {
        PHASE_IDS(); KARG(kp); unsigned char* ws = KWS(kp);
        const float* x = KIN(kp, 0); const float* ln_mix_even = KIN(kp, 1); const float* w_in = KIN(kp, 2); const float* w_out = KIN(kp, 15); const float* ln_ffn_even = KIN(kp, 16);
        const float* ffn_wg = KIN(kp, 17); const float* ffn_wu = KIN(kp, 18); const float* ffn_wd = KIN(kp, 19); const float* ln_mix_odd = KIN(kp, 20); const float* pool_w = KIN(kp, 21);
        const float* ln_ffn_odd = KIN(kp, 23); const float* moe_wg = KIN(kp, 25); const float* moe_wu = KIN(kp, 26); const float* moe_wd = KIN(kp, 27);
        bf16* WIN = (bf16*)(ws + WS_WIN); bf16* WOUT = (bf16*)(ws + WS_WOUT); bf16* WF1 = (bf16*)(ws + WS_WF1); bf16* WF2 = (bf16*)(ws + WS_WF2);
        bf16* WPL = (bf16*)(ws + WS_WPL); unsigned char* WM1 = ws + WS_WM1; unsigned char* WM2 = ws + WS_WM2; float* ROPE = (float*)(ws + WS_ROPE); bf16* SLOTA = (bf16*)(ws + WS_XN);
        LAS float* scr = (LAS float*)(lds + RING_OFF + wave * 16384);
        constexpr int I_IN = 16 * 80, I_OUT = 16 * 32, I_F1 = 16 * 88, I_F2 = 44 * 32, I_PL = 4 * 32, I_M1 = 8 * 16 * 112, I_M2 = 8 * 56 * 32;
        constexpr int NITEMS = I_IN + I_OUT + 2 * I_F1 + I_F2 + I_PL + 2 * I_M1 + I_M2;
        struct TrD { const float* wp; const float* gain; unsigned char* dst; int N, ldk, fp8; float sc; };
        auto desc = [&](int it) -> TrD {
            TrD d; int r = it; d.sc = 1.f; d.fp8 = 0; d.gain = nullptr;
            const float* W; int N, k0, n0, ldk; size_t drow0; unsigned char* WT;
            if (r < I_IN) { const int kb = r / 80, nb = r % 80; W = w_in; N = INW; k0 = 64 * kb; n0 = 32 * nb; d.gain = ln_mix_even; WT = (unsigned char*)WIN; drow0 = 32 * nb; ldk = 1024; }
            else if ((r -= I_IN) < I_OUT) { const int kb = r / 32, nb = r % 32; W = w_out; N = 1024; k0 = 64 * kb; n0 = 32 * nb; WT = (unsigned char*)WOUT; drow0 = 32 * nb; ldk = 1024; }
            else if ((r -= I_OUT) < 2 * I_F1) { const int up = r >= I_F1 ? 1 : 0, rr = r - up * I_F1, kb = rr / 88, nb = rr % 88; W = up ? ffn_wu : ffn_wg; N = FFND; k0 = 64 * kb; n0 = 32 * nb; d.gain = ln_ffn_even; WT = (unsigned char*)WF1; drow0 = (size_t)(256 * (n0 / 128) + (n0 % 128) + up * 128); ldk = 1024; }
            else if ((r -= 2 * I_F1) < I_F2) { const int kb = r / 32, nb = r % 32; W = ffn_wd; N = 1024; k0 = 64 * kb; n0 = 32 * nb; d.fp8 = 1; d.sc = 64.0f; WT = (unsigned char*)WF2; drow0 = 32 * nb; ldk = FFND; }
            else if ((r -= I_F2) < I_PL) { const int g = r / 32, rr = r % 32, kb = rr / 8, nb = rr % 8; W = pool_w + (size_t)g * 65536; N = 256; k0 = 64 * kb; n0 = 32 * nb; d.gain = ln_mix_odd + 256 * g; WT = (unsigned char*)WPL; drow0 = (size_t)(256 * g + 32 * nb); ldk = 256; }
            else if ((r -= I_PL) < 2 * I_M1) { const int up = r >= I_M1 ? 1 : 0, rr = r - up * I_M1, e = rr / 1792, r2 = rr % 1792, kb = r2 / 112, nb = r2 % 112; W = (up ? moe_wu : moe_wg) + (size_t)e * 1024 * EDIM; N = EDIM; k0 = 64 * kb; n0 = 32 * nb;
                d.gain = ln_ffn_odd; d.sc = 32.0f; d.fp8 = 1; WT = WM1; drow0 = (size_t)e * 7168 + (size_t)(256 * (n0 / 128) + (n0 % 128) + up * 128); ldk = 1024; }
            else { r -= 2 * I_M1; const int e = r / 1792, r2 = r % 1792, kb = r2 / 32, nb = r2 % 32; W = moe_wd + (size_t)e * EDIM * 1024; N = 1024; k0 = 64 * kb; n0 = 32 * nb; d.sc = 64.0f; d.fp8 = 1; WT = WM2; drow0 = (size_t)e * 1024 + 32 * nb; ldk = EDIM; }
            d.wp = W + (size_t)(k0 + (lane >> 5)) * N + n0 + (lane & 31); d.N = N; d.ldk = ldk; if (d.gain) d.gain += k0;
            d.dst = WT + (drow0 * (size_t)ldk + k0) * (d.fp8 ? 1 : 2);
            return d; };
        {
            int it = gw; bool have = it < NITEMS; TrD d{}; float v[32];
            if (have) { d = desc(it);
#pragma unroll
                for (int i = 0; i < 32; ++i) v[i] = __builtin_nontemporal_load(d.wp + (size_t)(2 * i) * d.N); }
            while (have) {
                const int itn = it + NGW; const bool haven = itn < NITEMS; TrD dn{}; float vn[32];
                if (haven) { dn = desc(itn);
#pragma unroll
                    for (int i = 0; i < 32; ++i) vn[i] = __builtin_nontemporal_load(dn.wp + (size_t)(2 * i) * dn.N); }
                const int c = lane & 7;
                f32x4 g0 = (f32x4){d.sc, d.sc, d.sc, d.sc}, g1 = g0;
                if (d.gain) { g0 = *(const f32x4*)(d.gain + 8 * c) * d.sc; g1 = *(const f32x4*)(d.gain + 8 * c + 4) * d.sc; }
#pragma unroll
                for (int i = 0; i < 32; ++i) scr[(2 * i + (lane >> 5)) * 33 + (lane & 31)] = v[i];
                LDS_WAIT(); asm volatile("" ::: "memory");
#pragma unroll
                for (int j = 0; j < 4; ++j) { const int n = (lane >> 3) + 8 * j; const LAS float* s = scr + (8 * c) * 33 + n;
                    const float e0 = s[0 * 33] * g0.x, e1 = s[1 * 33] * g0.y, e2 = s[2 * 33] * g0.z, e3 = s[3 * 33] * g0.w, e4 = s[4 * 33] * g1.x, e5 = s[5 * 33] * g1.y, e6 = s[6 * 33] * g1.z, e7 = s[7 * 33] * g1.w;
                    if (d.fp8) { pg8::u32x2 o; o.x = pg8::cvt4_fp8(e0, e1, e2, e3); o.y = pg8::cvt4_fp8(e4, e5, e6, e7); *(GAS pg8::u32x2*)(d.dst + (size_t)n * d.ldk + 8 * c) = o; }
                    else { v4u o; o.x = pk2(e0, e1); o.y = pk2(e2, e3); o.z = pk2(e4, e5); o.w = pk2(e6, e7); *(GAS v4u*)(d.dst + ((size_t)n * d.ldk + 8 * c) * 2) = o; } }
                LDS_WAIT(); asm volatile("" ::: "memory");
#pragma unroll
                for (int i = 0; i < 32; ++i) v[i] = vn[i];
                d = dn; it = itn; have = haven;
            }
        }
        for (int e = bid * (NWAVES * 64) + tid; e < SEQL * 8; e += G * NWAVES * 64) {
            const int pos = e >> 3, i = e & 7;
            const float inv = (i == 0) ? 1.000000000e+00f : (i == 1) ? 1.939227432e-01f : (i == 2) ? 3.760603070e-02f : (i == 3) ? 7.292664610e-03f : (i == 4) ? 1.414213562e-03f : (i == 5) ? 2.742481884e-04f : (i == 6) ? 5.318295734e-05f : 1.031338525e-05f;
            const float angf = (float)pos * inv; const double a = (double)angf;
            const double q = __builtin_rint(a * 0.63661977236758134308); const double rr = (a - q * 1.57079632679489655800) - q * 6.123233995736766036e-17; const int qi = (int)q & 3;
            const double r2 = rr * rr;
            const double sn = rr * (1.0 + r2 * (-1.0 / 6 + r2 * (1.0 / 120 + r2 * (-1.0 / 5040 + r2 * (1.0 / 362880 + r2 * (-1.0 / 39916800 + r2 * (1.0 / 6227020800.0)))))));
            const double cn = 1.0 + r2 * (-0.5 + r2 * (1.0 / 24 + r2 * (-1.0 / 720 + r2 * (1.0 / 40320 + r2 * (-1.0 / 3628800 + r2 * (1.0 / 479001600 + r2 * (-1.0 / 87178291200.0)))))));
            const double c = (qi == 0) ? cn : (qi == 1) ? -sn : (qi == 2) ? -cn : sn, s = (qi == 0) ? sn : (qi == 1) ? cn : (qi == 2) ? -sn : -cn;
            ROPE[2 * e] = (float)c; ROPE[2 * e + 1] = (float)s;
        }
        { const float* rg_wa = KIN(kp, 10); const float* rg_wx = KIN(kp, 12); bf16* RGW = (bf16*)(ws + WS_RGW);
          for (int e = bid * (NWAVES * 64) + tid; e < 2 * 8 * 64 * 64; e += G * NWAVES * 64) { const int k = e & 63, n = (e >> 6) & 63, hd = (e >> 12) & 7, g = e >> 15;
              RGW[e] = (bf16)f2bf((g ? rg_wx : rg_wa)[(size_t)(hd * 64 + k) * 64 + n]); } }
        float* XS = (float*)(ws + WS_XS);
        for (int m0 = gw * 4; m0 < NTOK; m0 += NGW * 4) {
            f32x4 v[4][4];
#pragma unroll
            for (int r = 0; r < 4; ++r) { const GAS f32x4* xr = (const GAS f32x4*)(x + (size_t)(m0 + r) * DMODEL) + lane;
#pragma unroll
                for (int j = 0; j < 4; ++j) v[r][j] = __builtin_nontemporal_load(xr + 64 * j); }
#pragma unroll
            for (int r = 0; r < 4; ++r) { float s2 = 0.f;
#pragma unroll
                for (int j = 0; j < 4; ++j) s2 += (v[r][j].x * v[r][j].x + v[r][j].y * v[r][j].y) + (v[r][j].z * v[r][j].z + v[r][j].w * v[r][j].w);
                const float rms = sqrtf(wave_sum(s2) * (1.f / DMODEL) + 1e-6f), rstd = 1.0f / rms;
                if (lane == 0) XS[m0 + r] = rms;
                GAS unsigned long long* o8 = (GAS unsigned long long*)(SLOTA + (size_t)(m0 + r) * DMODEL) + lane;
#pragma unroll
                for (int j = 0; j < 4; ++j) o8[64 * j] = (unsigned long long)pk2(v[r][j].x * rstd, v[r][j].y * rstd) | ((unsigned long long)pk2(v[r][j].z * rstd, v[r][j].w * rstd) << 32); }
        }
        if (BOTH(0) || rep_ == 0 && MK_REP == 0) GRID_BAR();
    }

    if (IN(1)) for (int rep_ = 0; rep_ < 1 + (MK_REP == 1 ? 1 : 0); ++rep_) {
        KARG(kp); unsigned char* ws = KWS(kp);
        bf16* WIN = (bf16*)(ws + WS_WIN); float* ROPE = (float*)(ws + WS_ROPE); bf16* SLOTA = (bf16*)(ws + WS_XN); bf16* PROJ = (bf16*)(ws + WS_PROJ);
        pg8::GSched S{}; S.so.init(NTOK, INW, G, bid); S.A = (const char*)SLOTA; S.a_pm = 256 * 1024 * 2; S.a_pn = 0; S.B = (const char*)WIN; S.b_pn = 256 * 1024 * 2; S.b_e = 0; S.rowidx = nullptr; S.pm0 = 0;
        pg8::EpiInProj E{PROJ, ROPE};
        pg8::gemm_phase2<pg8::EpiInProj, false, true>(lds + RING_OFF, S, 1024, 1024, 1024, E);
        if (BOTH(1) || rep_ == 0 && MK_REP == 1) GRID_BAR();
    }

    if (IN(2)) for (int rep_ = 0; rep_ < 1 + (MK_REP == 2 ? 1 : 0); ++rep_) {
        KARG(kp); unsigned char* ws = KWS(kp);
        const float* lam_q1 = KIN(kp, 3); const float* lam_k1 = KIN(kp, 4); const float* lam_q2 = KIN(kp, 5); const float* lam_k2 = KIN(kp, 6); const float* subln_g = KIN(kp, 7);
        const float* conv_w = KIN(kp, 8); const float* conv_b = KIN(kp, 9); const float* rg_wa = KIN(kp, 10); const float* rg_ba = KIN(kp, 11); const float* rg_wx = KIN(kp, 12); const float* rg_bx = KIN(kp, 13); const float* rg_lam = KIN(kp, 14);
        bf16* AR = (bf16*)(ws + WS_AR); bf16* PROJ = (bf16*)(ws + WS_PROJ);
#ifndef NO_RGLRU
        {
            PHASE_IDS();
            LAS float* XC = (LAS float*)(lds + RING_OFF);
            LAS bf16* XCB = (LAS bf16*)(lds + RING_OFF + 32768);
            LAS float* AA = (LAS float*)(lds + RING_OFF + 51200);
            LAS float* UU = (LAS float*)(lds + RING_OFF + 83968);
            LAS float* CST = (LAS float*)(lds + RING_OFF + 116736);
            LAS float* SP = CST + 192;
            LAS float* SH = SP + 512;
            LAS float* HIN = SH + 512;
            const bf16* RGW = (const bf16*)(ws + WS_RGW);
            gu64* SUMM = (gu64*)(ws + WS_SUMM);
            const int c = tid & 63, s = wave, fr = lane & 15, fq = lane >> 4;
            const int nsl = (G >= 64) ? (G >> 6) : 1;
            for (int chain = (G >= 64) ? (vcu & 63) : vcu; chain < 64 && (G < 64 || vcu < 64 * nsl); chain += (G >= 64) ? 64 : G) {
                const int b = chain >> 3, hd = chain & 7;
                const bf16* xbp = PROJ + (size_t)(b * SEQL) * INW + 1536 + hd * 64 + c;
                const bf16* gbp = PROJ + (size_t)(b * SEQL) * INW + 2048 + hd * 64 + c;
                bf16* rp = AR + (size_t)(b * SEQL) * 1024 + 512 + hd * 64 + c;
                if (tid < 64) { CST[c] = rg_ba[hd * 64 + c]; CST[64 + c] = rg_bx[hd * 64 + c]; CST[128 + c] = -8.0f * 1.4426950408889634f * log1pf(__expf(-rg_lam[hd * 64 + c])); }
                const float cw0 = conv_w[0 * 512 + hd * 64 + c], cw1 = conv_w[1 * 512 + hd * 64 + c], cw2 = conv_w[2 * 512 + hd * 64 + c], cw3 = conv_w[3 * 512 + hd * 64 + c], cb = conv_b[hd * 64 + c];
                bf16x8 wf[2][4][2];
#pragma unroll
                for (int g = 0; g < 2; ++g)
#pragma unroll
                    for (int nb = 0; nb < 4; ++nb)
#pragma unroll
                        for (int ks = 0; ks < 2; ++ks) wf[g][nb][ks] = *(const bf16x8*)(RGW + (size_t)(((g * 8 + hd) * 64 + 16 * nb + fr) * 64 + 32 * ks + 8 * fq));
                float carry = 0.f; int cseg = 0;
                LAS float* SPb = SP; LAS float* SHb = SP + 1024; LAS float* HINb = SP + 2048;
                float xw[19], gbo[16], hlo[16], cpo[16];
                unsigned long long lv[4]; float Pprev = 1.f, Hprev = 0.f; int lbn = 0;
#pragma unroll
                for (int j = 0; j < 4; ++j) lv[j] = 0x000000003f800001ull;
                const int seg0 = (G >= 64) ? (vcu >> 6) : 0;
                { const int t0 = seg0 * 128 + s * 16;
#pragma unroll
                  for (int j = 0; j < 19; ++j) { const int t = t0 - 3 + j; xw[j] = (t >= 0) ? bf2f(xbp[(size_t)(t < 0 ? 0 : t) * INW]) : 0.f; } }
                int k = 0, t0o = 0;
                for (int seg = seg0; ; seg += nsl, ++k) {
                    const bool act = seg < 32; const int t0 = seg * 128 + s * 16; const int pb = k & 1;
                    float hl[16], cp[16];
                    if (act) {
#pragma unroll
                        for (int i = 0; i < 16; ++i) { const float v = cb + ((cw0 * xw[i] + cw1 * xw[i + 1]) + (cw2 * xw[i + 2] + cw3 * xw[i + 3])); XC[(s * 16 + i) * 64 + c] = v; XCB[(s * 16 + i) * 72 + c] = (bf16)f2bf(v); }
                    }
                    __syncthreads();
                    if (k > 0) {
#pragma unroll
                        for (int i = 0; i < 16; ++i) gbo[i] = bf2f(gbp[(size_t)(t0o + i) * INW]);
                    }
                    if (act) {
                        if (seg + nsl < 32) { const int t0n = (seg + nsl) * 128 + s * 16;
#pragma unroll
                          for (int j = 0; j < 19; ++j) xw[j] = bf2f(xbp[(size_t)(t0n - 3 + j) * INW]); }
                        {
                            const bf16x8 xf0 = *(const LAS bf16x8*)(XCB + (s * 16 + fr) * 72 + 8 * fq), xf1 = *(const LAS bf16x8*)(XCB + (s * 16 + fr) * 72 + 32 + 8 * fq);
#pragma unroll
                            for (int nb = 0; nb < 4; ++nb) {
                                f32x4 da = (f32x4){0.f, 0.f, 0.f, 0.f}, dx = (f32x4){0.f, 0.f, 0.f, 0.f};
                                da = __builtin_amdgcn_mfma_f32_16x16x32_bf16(wf[0][nb][0], xf0, da, 0, 0, 0); da = __builtin_amdgcn_mfma_f32_16x16x32_bf16(wf[0][nb][1], xf1, da, 0, 0, 0);
                                dx = __builtin_amdgcn_mfma_f32_16x16x32_bf16(wf[1][nb][0], xf0, dx, 0, 0, 0); dx = __builtin_amdgcn_mfma_f32_16x16x32_bf16(wf[1][nb][1], xf1, dx, 0, 0, 0);
                                const int c0 = 16 * nb + 4 * fq, t = s * 16 + fr;
                                const f32x4 ba4 = *(const LAS f32x4*)(CST + c0), bx4 = *(const LAS f32x4*)(CST + 64 + c0), sp4 = *(const LAS f32x4*)(CST + 128 + c0), xc4 = *(const LAS f32x4*)(XC + t * 64 + c0);
                                f32x4 a4, u4;
#pragma unroll
                                for (int j = 0; j < 4; ++j) {
                                    const float r = __builtin_amdgcn_rcpf(1.0f + __builtin_amdgcn_exp2f(-1.4426950408889634f * (da[j] + ba4[j])));
                                    const float ig = __builtin_amdgcn_rcpf(1.0f + __builtin_amdgcn_exp2f(-1.4426950408889634f * (dx[j] + bx4[j])));
                                    const float a = __builtin_amdgcn_exp2f(r * sp4[j]);
                                    a4[j] = a; u4[j] = __builtin_amdgcn_sqrtf(fmaxf(1.0f - a * a, 0.f)) * (ig * xc4[j]);
                                }
                                *(LAS f32x4*)(AA + t * 64 + c0) = a4; *(LAS f32x4*)(UU + t * 64 + c0) = u4;
                            }
                        }
                    }
                    __syncthreads();
                    if (act) {
                        float h = 0.f, P = 1.f;
#pragma unroll
                        for (int i = 0; i < 16; ++i) { const float a = AA[(s * 16 + i) * 64 + c], uu = UU[(s * 16 + i) * 64 + c]; h = a * h + uu; P *= a; hl[i] = h; cp[i] = P; }
                        SPb[pb * 512 + s * 64 + c] = P; SHb[pb * 512 + s * 64 + c] = h;
                    }
                    __syncthreads();
                    if (wave == 0) {
                        if (k > 0) {
                            const int segp = seg - nsl; unsigned spins = 0;
                            for (;;) { bool ok = true;
#pragma unroll
                                for (int j = 0; j < 4; ++j) ok = ok && ((unsigned)lv[j] & 1u);
                                if (__all(ok)) break;
                                __builtin_amdgcn_s_sleep(1);
#pragma unroll
                                for (int j = 0; j < 4; ++j) if (j < lbn) lv[j] = __hip_atomic_load(SUMM + (size_t)(chain * 32 + cseg + j) * 64 + c, RLX_AGENT);
                                if (++spins > (1u << 22)) { if (lane == 0) __hip_atomic_store(ctl + CW_TMO, 1u, RLX_AGENT); break; } }
#pragma unroll
                            for (int j = 0; j < 4; ++j) carry = __uint_as_float((unsigned)lv[j]) * carry + __uint_as_float((unsigned)(lv[j] >> 32));
                            HINb[(pb ^ 1) * 64 + c] = carry;
                            carry = Pprev * carry + Hprev; cseg = segp + 1;
                        }
                        if (act) {
                            float Ps = 1.f, Hs = 0.f;
#pragma unroll
                            for (int s2 = 0; s2 < 8; ++s2) { const float p2 = SPb[pb * 512 + s2 * 64 + c]; Hs = p2 * Hs + SHb[pb * 512 + s2 * 64 + c]; Ps *= p2; }
                            const int uidx = chain * 32 + seg;
                            Ps = __uint_as_float(__float_as_uint(Ps) | 1u);
                            __hip_atomic_store(SUMM + (size_t)uidx * 64 + c, ((unsigned long long)__float_as_uint(Hs) << 32) | __float_as_uint(Ps), RLX_AGENT);
                            Pprev = Ps; Hprev = Hs;
                            const int cs = (k > 0) ? (seg - nsl + 1) : 0; lbn = seg - cs;
#pragma unroll
                            for (int j = 0; j < 4; ++j) lv[j] = (j < lbn) ? __hip_atomic_load(SUMM + (size_t)(chain * 32 + cs + j) * 64 + c, RLX_AGENT) : 0x000000003f800001ull;
                            if (k == 0) cseg = 0;
                        }
                    }
                    __syncthreads();
                    if (k > 0) {
                        const int po = pb ^ 1;
                        float base = HINb[po * 64 + c];
                        for (int s2 = 0; s2 < s; ++s2) base = SPb[po * 512 + s2 * 64 + c] * base + SHb[po * 512 + s2 * 64 + c];
#pragma unroll
                        for (int i = 0; i < 16; ++i) { const float hh = hlo[i] + cpo[i] * base; rp[(size_t)(t0o + i) * 1024] = (bf16)f2bf(hh * gelu_tanh(gbo[i])); }
                    }
                    if (!act) break;
#pragma unroll
                    for (int i = 0; i < 16; ++i) { hlo[i] = hl[i]; cpo[i] = cp[i]; }
                    t0o = t0;
                }
                __syncthreads();
            }
        }
#endif
#ifndef NO_ATTN
        {
            float lam;
            {   PHASE_IDS();
                const float d1 = wave_sum(lam_q1[lane] * lam_k1[lane]), d2 = wave_sum(lam_q2[lane] * lam_k2[lane]);
                lam = __uint_as_float(__builtin_amdgcn_readfirstlane(__float_as_uint(expf(d1) - expf(d2) + 0.2f))); }
            const attn_body::AttnTensors AT{(const attn_body::bf16*)PROJ, (const attn_body::bf16*)PROJ + 512, (const attn_body::bf16*)PROJ + 1024, (attn_body::bf16*)AR, lam, subln_g};
            const attn_body::StaticOrder SA(G, vcu);
#ifdef REP_ATTN
            for (int ra_ = 0; ra_ < 2; ++ra_)
#endif
#ifdef ATTN_V1
            attn_body::attn_phase<attn_body::StaticOrder>((char*)lds_raw + RING_OFF, AT, SA);
#else
            { const attn_body::StaticOrder2 SA2(G, vcu); attn_body::attn_phase2<attn_body::StaticOrder2>((char*)lds_raw + RING_OFF, AT, SA2); }
#endif
        }
#endif
        if (BOTH(2) || rep_ == 0 && MK_REP == 2) GRID_BAR();
    }


    if (IN(4)) for (int rep_ = 0; rep_ < 1 + (MK_REP == 4 ? 1 : 0); ++rep_) {
        KARG(kp); unsigned char* ws = KWS(kp);
        bf16* WOUT = (bf16*)(ws + WS_WOUT); bf16* XN = (bf16*)(ws + WS_XN); bf16* AR = (bf16*)(ws + WS_AR); bf16* H1B = (bf16*)(ws + WS_H1B); float* SSQ1 = (float*)(ws + WS_SSQ1);
        pg8::GSched S{}; S.so.init(NTOK, 1024, G, bid); S.A = (const char*)AR; S.a_pm = 256 * 1024 * 2; S.B = (const char*)WOUT; S.b_pn = 256 * 1024 * 2;
        pg8::EpiResid<true, false, true, false, true> E{nullptr, XN, nullptr, H1B, SSQ1, nullptr, (const float*)(ws + WS_XS)};
        pg8::gemm_phase2<pg8::EpiResid<true, false, true, false, true>, false, true>(lds + RING_OFF, S, 1024, 1024, 1024, E);
        if (BOTH(4) || rep_ == 0 && MK_REP == 4) GRID_BAR();
    }

    if (IN(5)) for (int rep_ = 0; rep_ < 1 + (MK_REP == 5 ? 1 : 0); ++rep_) {
        KARG(kp); unsigned char* ws = KWS(kp);
        bf16* WF1 = (bf16*)(ws + WS_WF1); bf16* H1B = (bf16*)(ws + WS_H1B); bf16* HID = (bf16*)(ws + WS_HID); float* SSQ1 = (float*)(ws + WS_SSQ1);
        pg8::GSched S{}; S.so.init(NTOK, 2 * FFND, G, bid); S.A = (const char*)H1B; S.a_pm = 256 * 1024 * 2; S.B = (const char*)WF1; S.b_pn = 256 * 1024 * 2;
        pg8::EpiSwiGLU8T<true> E{(unsigned char*)HID, FFND, 8.0f, SSQ1};
        pg8::gemm_phase2<pg8::EpiSwiGLU8T<true>, false, true>(lds + RING_OFF, S, 1024, 1024, 1024, E);
        if (BOTH(5) || rep_ == 0 && MK_REP == 5) GRID_BAR();
    }

    if (IN(6)) for (int rep_ = 0; rep_ < 1 + (MK_REP == 6 ? 1 : 0); ++rep_) {
        KARG(kp); unsigned char* ws = KWS(kp);
        bf16* WF2 = (bf16*)(ws + WS_WF2); bf16* HID = (bf16*)(ws + WS_HID); bf16* H1B = (bf16*)(ws + WS_H1B); float* SSQ2 = (float*)(ws + WS_SSQ2);
        pg8::GSched S{}; S.so.init(NTOK, 1024, G, bid); S.A = (const char*)HID; S.a_pm = 256 * FFND; S.B = (const char*)WF2; S.b_pn = 256 * FFND;
        pg8::EpiResid<true, false, true> E{nullptr, H1B, nullptr, H1B, SSQ2, nullptr, nullptr};
        pg8::gemm_phase2<pg8::EpiResid<true, false, true>, false, true, true>(lds + RING_OFF, S, FFND / 2, FFND / 2, FFND / 2, E, 121, 124);
        if (BOTH(6) || rep_ == 0 && MK_REP == 6) GRID_BAR();
    }

    if (IN(7)) for (int rep_ = 0; rep_ < 1 + (MK_REP == 7 ? 1 : 0); ++rep_) {
        PHASE_IDS(); KARG(kp); unsigned char* ws = KWS(kp); const bf16* HB = (const bf16*)(ws + WS_H1B);
        bf16* SLOTA = (bf16*)(ws + WS_XN); float* SSQ2 = (float*)(ws + WS_SSQ2);
        LAS float* RS = (LAS float*)(lds + RING_OFF);
        for (int blk = bid; blk < NTOK / 128; blk += G) {
            const int t0 = blk * 128, pos0 = t0 & (SEQL - 1);
            if (tid < 144) { const int row = t0 - 16 + tid; float rs = 0.f;
                if (row >= 0) { const f32x4* sp = (const f32x4*)(SSQ2 + (size_t)row * 16); const f32x4 t = (sp[0] + sp[1]) + (sp[2] + sp[3]); rs = 1.0f / sqrtf(((t[0] + t[1]) + (t[2] + t[3])) * (1.0f / 1024.0f) + 1e-6f); }
                RS[tid] = rs; }
            __syncthreads();
            const int w = 2 << (tid >> 7);
            const bf16* hp = HB + 2 * tid;
#define LD2(p) ({ const unsigned u_ = *(const unsigned*)(p); make_float2(__uint_as_float(u_ << 16), __uint_as_float(u_ & 0xffff0000u)); })
            float s0 = 0.f, s1 = 0.f;
            for (int j = 1; j <= 16; ++j) if (j <= w && pos0 - j >= 0) { const float2 v = LD2(hp + (size_t)(t0 - j) * 1024); const float rs = RS[16 - j]; s0 += v.x * rs; s1 += v.y * rs; }
            for (int i0 = 0; i0 < 128; i0 += 8) {
                float2 vn[8], vo[8];
#pragma unroll
                for (int i = 0; i < 8; ++i) { vn[i] = LD2(hp + (size_t)(t0 + i0 + i) * 1024); const int ro = t0 + i0 + i - w; vo[i] = (pos0 + i0 + i - w >= 0) ? LD2(hp + (size_t)(ro < 0 ? 0 : ro) * 1024) : make_float2(0.f, 0.f); }
#pragma unroll
                for (int i = 0; i < 8; ++i) {
                    const int pos = pos0 + i0 + i; const float rs = RS[16 + i0 + i];
                    const float a0 = vn[i].x * rs, a1 = vn[i].y * rs;
                    s0 += a0; s1 += a1;
                    if (pos - w >= 0) { const float ro = RS[16 + i0 + i - w]; s0 -= vo[i].x * ro; s1 -= vo[i].y * ro; }
                    const float ic = 1.0f / (float)((pos + 1 < w) ? pos + 1 : w);
                    *(GAS unsigned*)(SLOTA + (size_t)(t0 + i0 + i) * 1024 + 2 * tid) = pk2(s0 * ic - a0, s1 * ic - a1);
                }
            }
            __syncthreads();
        }
#undef LD2
        if (BOTH(7) || rep_ == 0 && MK_REP == 7) GRID_BAR();
    }

    if (IN(8)) for (int rep_ = 0; rep_ < 1 + (MK_REP == 8 ? 1 : 0); ++rep_) {
        KARG(kp); unsigned char* ws = KWS(kp); bf16* HB = (bf16*)(ws + WS_H1B); const float* pool_scale = KIN(kp, 22);
        bf16* SLOTA = (bf16*)(ws + WS_XN); bf16* WPL = (bf16*)(ws + WS_WPL);
        pg8::GSched S{}; S.so.init(NTOK, 1024, G, bid); S.A = (const char*)SLOTA; S.a_pm = 256 * 1024 * 2; S.a_pn = 512; S.B = (const char*)WPL; S.b_pn = 256 * 256 * 2;
        pg8::EpiPool E{HB, pool_scale};
        pg8::gemm_phase2<pg8::EpiPool, false, true>(lds + RING_OFF, S, 256, 1024, 256, E);
        if (BOTH(8) || rep_ == 0 && MK_REP == 8) GRID_BAR();
    }

    if (IN(9)) for (int rep_ = 0; rep_ < 1 + (MK_REP == 9 ? 1 : 0); ++rep_) {
        PHASE_IDS(); KARG(kp); unsigned char* ws = KWS(kp); const bf16* HB = (const bf16*)(ws + WS_H1B); const float* ln_ffn_odd = KIN(kp, 23); const float* router_w = KIN(kp, 24);
        bf16* SLOTA = (bf16*)(ws + WS_SLOTA); v4u* TOPK = (v4u*)(ws + WS_TOPK); int* CNT = (int*)(ws + WS_CNT);
        LAS float* GW = (LAS float*)(lds + RING_OFF);
        LAS int* LC = (LAS int*)(lds + RING_OFF + 32768);
        for (int i = tid; i < 8192; i += NWAVES * 64) GW[i] = ln_ffn_odd[i >> 3] * router_w[i];
        __syncthreads();
        for (int blk = bid; blk < NTOK / 128; blk += G) {
            if (tid < 8) LC[tid] = 0;
            __syncthreads();
            for (int r0 = wave * 4; r0 < 128; r0 += NWAVES * 4) {
                f32x4 v[4][4]; float ss[4]; float lg[4][8];
#pragma unroll
                for (int r = 0; r < 4; ++r) { const GAS unsigned long long* xr = (const GAS unsigned long long*)(HB + (size_t)(blk * 128 + r0 + r) * DMODEL) + lane;
#pragma unroll
                    for (int j = 0; j < 4; ++j) { const unsigned long long hw = __builtin_nontemporal_load(xr + 64 * j); const unsigned h0 = (unsigned)hw, h1 = (unsigned)(hw >> 32);
                        v[r][j].x = __uint_as_float(h0 << 16); v[r][j].y = __uint_as_float(h0 & 0xffff0000u); v[r][j].z = __uint_as_float(h1 << 16); v[r][j].w = __uint_as_float(h1 & 0xffff0000u); }
                    ss[r] = 0.f;
#pragma unroll
                    for (int e = 0; e < 8; ++e) lg[r][e] = 0.f; }
#pragma unroll
                for (int j = 0; j < 4; ++j) {
                    const LAS f32x4* gp = (const LAS f32x4*)(GW + (size_t)(4 * (lane + 64 * j)) * 8);
#pragma unroll
                    for (int q = 0; q < 4; ++q) { const f32x4 ga = gp[2 * q], gb = gp[2 * q + 1];
#pragma unroll
                        for (int r = 0; r < 4; ++r) { const float xv = v[r][j][q]; ss[r] += xv * xv;
                            lg[r][0] += xv * ga.x; lg[r][1] += xv * ga.y; lg[r][2] += xv * ga.z; lg[r][3] += xv * ga.w; lg[r][4] += xv * gb.x; lg[r][5] += xv * gb.y; lg[r][6] += xv * gb.z; lg[r][7] += xv * gb.w; } } }
#pragma unroll
                for (int r = 0; r < 4; ++r) {
                    const int m = blk * 128 + r0 + r;
                    const float sst = wave_sum(ss[r]); float l[8];
#pragma unroll
                    for (int e = 0; e < 8; ++e) l[e] = wave_sum(lg[r][e]);
                    const float rstd = 1.0f / sqrtf(sst * (1.f / DMODEL) + 1e-6f);
                    int e1 = 0; float l1 = l[0];
#pragma unroll
                    for (int e = 1; e < 8; ++e) if (l[e] > l1) { l1 = l[e]; e1 = e; }
                    int e2 = -1; float l2 = -3.0e38f;
#pragma unroll
                    for (int e = 0; e < 8; ++e) if (e != e1 && l[e] > l2) { l2 = l[e]; e2 = e; }
                    const float g1 = 1.0f / (1.0f + expf((l2 - l1) * rstd)), g2 = 1.0f - g1;
                    GAS unsigned* o4 = (GAS unsigned*)((unsigned char*)SLOTA + (size_t)m * DMODEL) + lane;
                    const float r4 = rstd * 4.0f;
#pragma unroll
                    for (int j = 0; j < 4; ++j) o4[64 * j] = pg8::cvt4_fp8(v[r][j].x * r4, v[r][j].y * r4, v[r][j].z * r4, v[r][j].w * r4);
                    if (lane == 0) { v4u tk; tk.x = (unsigned)e1; tk.y = (unsigned)e2; tk.z = __builtin_bit_cast(unsigned, g1); tk.w = __builtin_bit_cast(unsigned, g2); TOPK[m] = tk;
                        atomicAdd((int*)(LC + e1), 1); atomicAdd((int*)(LC + e2), 1); }
                }
            }
            __syncthreads();
            if (tid < 8) CNT[blk * 8 + tid] = LC[tid];
            __syncthreads();
        }
        if (BOTH(9) || rep_ == 0 && MK_REP == 9) GRID_BAR();
    }

    if (IN(10)) for (int rep_ = 0; rep_ < 1 + (MK_REP == 10 ? 1 : 0); ++rep_) {
        PHASE_IDS(); KARG(kp); unsigned char* ws = KWS(kp);
        v4u* TOPK = (v4u*)(ws + WS_TOPK); int* CNT = (int*)(ws + WS_CNT); int* STOK = (int*)(ws + WS_STOK); int* SSLOT = (int*)(ws + WS_SSLOT); float* SGATE = (float*)(ws + WS_SGATE); int* TINFO = (int*)(ws + WS_TINFO);
        LAS int* LCNT = (LAS int*)(lds + RING_OFF);
        LAS int* LE = LCNT + 2048;
        LAS float* LG = (LAS float*)(LE + 256);
        LAS int* LT = (LAS int*)(LG + 256);
        LAS int* PT = LT + 32;
        LAS int* WC = PT + 1024;
        for (int blk = bid; blk < NTOK / 128; blk += G) {
            for (int i = tid; i < 2048; i += NWAVES * 64) LCNT[i] = CNT[i];
            if (tid < 128) { const v4u tk = TOPK[blk * 128 + tid]; const unsigned tz = tk.z, tw = tk.w;
                LE[2 * tid] = (int)tk.x; LE[2 * tid + 1] = (int)tk.y; LG[2 * tid] = __uint_as_float(tz); LG[2 * tid + 1] = __uint_as_float(tw); }
            __syncthreads();
            { const int e = tid & 7, q = tid >> 3; int t = 0, p = 0;
#pragma unroll
              for (int j = 0; j < 4; ++j) { const int b2 = 4 * q + j; const int c = LCNT[b2 * 8 + e]; t += c; if (b2 < blk) p += c; }
              PT[q * 8 + e] = t; PT[512 + q * 8 + e] = p; }
            int myE = -1, rankw = 0;
            if (tid < 256) {
                myE = LE[tid];
#pragma unroll
                for (int ee = 0; ee < 8; ++ee) { const unsigned long long mk = __ballot(myE == ee);
                    if (myE == ee) rankw = __popcll(mk & ((1ull << lane) - 1ull));
                    if (lane == 0) WC[wave * 8 + ee] = __popcll(mk); }
            }
            __syncthreads();
            if (tid < 8) { int t = 0, p = 0; for (int q = 0; q < 64; ++q) { t += PT[q * 8 + tid]; p += PT[512 + q * 8 + tid]; } LT[tid] = t; LT[8 + tid] = p; }
            __syncthreads();
            if (tid < 8) { int base = 0; for (int e2 = 0; e2 < tid; ++e2) base += (LT[e2] + 255) & ~255; LT[16 + tid] = base; }
            __syncthreads();
            if (tid < 256 && myE >= 0) {
                int pos = LT[16 + myE] + LT[8 + myE] + rankw;
                for (int w2 = 0; w2 < wave; ++w2) pos += WC[w2 * 8 + myE];
                STOK[pos] = blk * 128 + (tid >> 1); SSLOT[pos] = 2 * (blk * 128) + tid; SGATE[pos] = LG[tid];
            }
            if (blk == 0) {
                for (int e = 0; e < 8; ++e) { const int base = LT[16 + e], tot = LT[e], padded = (tot + 255) & ~255;
                    for (int q = base + tot + tid; q < base + padded; q += NWAVES * 64) { STOK[q] = 0; SSLOT[q] = -1; SGATE[q] = 0.f; }
                    if (tid == 0) { TINFO[1 + e] = base >> 8; if (e == 7) { TINFO[9] = (base + padded) >> 8; TINFO[0] = (base + padded) >> 8; } } }
            }
            __syncthreads();
        }
        if (BOTH(10) || rep_ == 0 && MK_REP == 10) GRID_BAR();
    }

    if (IN(11)) for (int rep_ = 0; rep_ < 1 + (MK_REP == 11 ? 1 : 0); ++rep_) {
        KARG(kp); unsigned char* ws = KWS(kp); const int* TINFO = (const int*)(ws + WS_TINFO);
        int ti[10];
#pragma unroll
        for (int j = 0; j < 10; ++j) ti[j] = __builtin_amdgcn_readfirstlane(TINFO[j]);
        int nM = ti[0]; if (nM > MAXTILES) nM = MAXTILES;
        if (nM > 0) {
            pg8::GSched S{}; S.so.init(nM * 256, 2 * EDIM, G, bid); S.A = (const char*)(ws + WS_SLOTA); S.a_pm = 0; S.a_pn = 0; S.B = (const char*)(ws + WS_WM1); S.b_pn = 256 * 1024; S.b_e = 7168 * 1024;
#pragma unroll
            for (int j = 0; j < 9; ++j) S.tb[j] = ti[1 + j];
            S.rowidx = (const int*)(ws + WS_STOK); S.pm0 = 0;
            pg8::EpiSwiGLU8 E{ws + WS_HIDS, EDIM, 8.0f, nullptr};
            pg8::gemm_phase2<pg8::EpiSwiGLU8, true, true, true>(lds + RING_OFF, S, 512, 512, 512, E, 122, 125);
        }
        if (BOTH(11) || rep_ == 0 && MK_REP == 11) GRID_BAR();
    }
    if (IN(12)) for (int rep_ = 0; rep_ < 1 + (MK_REP == 12 ? 1 : 0); ++rep_) {
        KARG(kp); unsigned char* ws = KWS(kp); const int* TINFO = (const int*)(ws + WS_TINFO);
        int ti[10];
#pragma unroll
        for (int j = 0; j < 10; ++j) ti[j] = __builtin_amdgcn_readfirstlane(TINFO[j]);
        int nM = ti[0]; if (nM > MAXTILES) nM = MAXTILES;
        if (nM > 0) {
            pg8::GSched S{}; S.so.init(nM * 256, 1024, G, bid); S.A = (const char*)(ws + WS_HIDS); S.a_pm = 256 * EDIM; S.a_pn = 0; S.B = (const char*)(ws + WS_WM2); S.b_pn = 256 * EDIM; S.b_e = 1024 * EDIM;
#pragma unroll
            for (int j = 0; j < 9; ++j) S.tb[j] = ti[1 + j];
            S.rowidx = nullptr; S.pm0 = 0;
            pg8::EpiScatter E{ws + WS_Y, (const int*)(ws + WS_SSLOT), (const float*)(ws + WS_SGATE), 0};
            pg8::gemm_phase2<pg8::EpiScatter, false, true, true>(lds + RING_OFF, S, EDIM / 2, EDIM / 2, EDIM / 2, E, 121, 124);
        }
        if (BOTH(12) || rep_ == 0 && MK_REP == 12) GRID_BAR();
    }

    if (IN(PH_FINAL)) {
        PHASE_IDS(); KARG(kp); unsigned char* ws = KWS(kp); float* H = KOUT(kp); const bf16* HB = (const bf16*)(ws + WS_H1B); const float* final_g = KIN(kp, 28); const unsigned char* YB = ws + WS_Y;
        unsigned poison = __hip_atomic_load(ctl + CW_BAR + XB_TMO, RLX_AGENT);
        for (int m0 = gw * 2; m0 < NTOK; m0 += NGW * 2) {
            f32x4 v[2][4]; unsigned ya[2][4], yb[2][4]; unsigned long long hw[2][4];
#pragma unroll
            for (int r = 0; r < 2; ++r) { const int m = m0 + r;
                const GAS unsigned long long* xr = (const GAS unsigned long long*)(HB + (size_t)m * DMODEL) + lane;
                const GAS unsigned* y0 = (const GAS unsigned*)(YB + (size_t)(2 * m) * DMODEL) + lane;
                const GAS unsigned* y1 = (const GAS unsigned*)(YB + (size_t)(2 * m + 1) * DMODEL) + lane;
#pragma unroll
                for (int j = 0; j < 4; ++j) { hw[r][j] = __builtin_nontemporal_load(xr + 64 * j); ya[r][j] = __builtin_nontemporal_load(y0 + 64 * j); yb[r][j] = __builtin_nontemporal_load(y1 + 64 * j); } }
#pragma unroll
            for (int r = 0; r < 2; ++r) { float s = 0.f;
#pragma unroll
                for (int j = 0; j < 4; ++j) { const unsigned a = ya[r][j], b = yb[r][j];
                    { const unsigned long long hq = hw[r][j]; const unsigned h0 = (unsigned)hq, h1 = (unsigned)(hq >> 32);
                      v[r][j].x = __uint_as_float(h0 << 16); v[r][j].y = __uint_as_float(h0 & 0xffff0000u); v[r][j].z = __uint_as_float(h1 << 16); v[r][j].w = __uint_as_float(h1 & 0xffff0000u); }
                    const auto al = __builtin_amdgcn_cvt_pk_f32_fp8((int)a, false), ah = __builtin_amdgcn_cvt_pk_f32_fp8((int)a, true);
                    const auto bl = __builtin_amdgcn_cvt_pk_f32_fp8((int)b, false), bh = __builtin_amdgcn_cvt_pk_f32_fp8((int)b, true);
                    v[r][j].x += (al[0] + bl[0]) * 0.0625f; v[r][j].y += (al[1] + bl[1]) * 0.0625f; v[r][j].z += (ah[0] + bh[0]) * 0.0625f; v[r][j].w += (ah[1] + bh[1]) * 0.0625f;
                    s += (v[r][j].x * v[r][j].x + v[r][j].y * v[r][j].y) + (v[r][j].z * v[r][j].z + v[r][j].w * v[r][j].w); }
                float rstd = 1.0f / sqrtf(wave_sum(s) * (1.f / DMODEL) + 1e-6f);
                if (poison) rstd = __builtin_nanf("");
                GAS f32x4* xo = (GAS f32x4*)(H + (size_t)(m0 + r) * DMODEL) + lane;
#pragma unroll
                for (int j = 0; j < 4; ++j) { const f32x4 g = *(const f32x4*)(final_g + 4 * (lane + 64 * j)); __builtin_nontemporal_store(v[r][j] * rstd * g, xo + 64 * j); } }
        }
    }
#undef IN
#undef BOTH
#undef GRID_BAR
}


#ifndef MK_MAXPH
#define MK_MAXPH PH_END
#endif
#ifndef MK_PER_PHASE
#define MK_PER_PHASE 0
#endif
extern "C" void kernel_launch(void* const* d_in, const int* in_sizes, int n_in, void* d_out, int out_size, void* d_ws, size_t ws_size, hipStream_t stream) {
    static int grid = 0;
    if (grid == 0) {
        if (n_in != 29 || in_sizes[0] != NTOK * DMODEL || out_size != NTOK * DMODEL || ws_size < WS_END) { fprintf(stderr, "kernel_launch: unexpected shapes / workspace (%d inputs, ws %zu); nothing launched\n", n_in, ws_size); grid = -1; return; }
        int dev = 0, cus = 0, per_cu = 0;
        if (hipGetDevice(&dev) != hipSuccess || hipDeviceGetAttribute(&cus, hipDeviceAttributeMultiprocessorCount, dev) != hipSuccess) { grid = -1; return; }
        if (hipFuncSetAttribute((const void*)mk_fwd, hipFuncAttributeMaxDynamicSharedMemorySize, LDS_BYTES) != hipSuccess) { fprintf(stderr, "kernel_launch: hipFuncSetAttribute failed\n"); grid = -1; return; }
        if (hipOccupancyMaxActiveBlocksPerMultiprocessor(&per_cu, (const void*)mk_fwd, NWAVES * 64, LDS_BYTES) != hipSuccess || per_cu < 1) { fprintf(stderr, "kernel_launch: occupancy query reports %d\n", per_cu); }
        (void)hipGetLastError();
        grid = cus;
    }
    if (grid < 0) return;
    if (hipMemsetAsync((char*)d_ws + WS_CTL, 0, CTL_ZERO_BYTES, stream) != hipSuccess) return;
    Args a{};
    for (int i = 0; i < 29; ++i) a.in[i] = (const float*)d_in[i];
    a.out = (float*)d_out; a.ws = (unsigned char*)d_ws;
#if MK_PER_PHASE
    for (int p = 0; p < MK_MAXPH; ++p) { a.ph_lo = p; a.ph_hi = p + 1; hipLaunchKernelGGL(mk_fwd, dim3(grid), dim3(NWAVES * 64), LDS_BYTES, stream, a); }
#else
    a.ph_lo = 0; a.ph_hi = PH_END; hipLaunchKernelGGL(mk_fwd, dim3(grid), dim3(NWAVES * 64), LDS_BYTES, stream, a);
#endif
}
```
